# Optimizing an MI355X kernel written in HIP

```python
import math
import jax, jax.numpy as jnp
from jax import lax
import numpy as np

D_MODEL = 1024
BATCH = 4
SEQ = 8192
DEPTH = 2

GRID_W = 64
CTX_LEN = 256
NORM_EPS = 1e-6
Q_BLOCK = 128
ROPE_THETA = 10000.0

MLA_HEADS = 6
MLA_NOPE_DIM = 64
MLA_ROPE_DIM = 32
MLA_QK_DIM = MLA_NOPE_DIM + MLA_ROPE_DIM
MLA_V_DIM = 64
MLA_Q_RANK = 384
MLA_KV_RANK = 256
MLA_WIDTH = MLA_HEADS * MLA_V_DIM

SWA_HEADS = 6
SWA_KV_HEADS = 2
SWA_GROUP = SWA_HEADS // SWA_KV_HEADS
SWA_HEAD_DIM = 64
SWA_WINDOW = 128
SWA_BLOCK = 128
SWA_BAND = SWA_BLOCK + 2 * SWA_WINDOW
SWA_WIDTH = SWA_HEADS * SWA_HEAD_DIM

HY_WIDTH = 256
HY_SHORT = 3
HY_BANDS = 8
HY_EMB = 1 + 2 * HY_BANDS
HY_HIDDEN = 64
HY_DECAY_FAST = math.log(1e-2) / 0.3
HY_DECAY_SLOW = math.log(1e-2) / 1.5

D_MIX = MLA_WIDTH + SWA_WIDTH + HY_WIDTH
IN_SIZES = (MLA_Q_RANK, MLA_KV_RANK, MLA_ROPE_DIM, MLA_WIDTH,
            SWA_HEADS * SWA_HEAD_DIM, SWA_KV_HEADS * SWA_HEAD_DIM, SWA_KV_HEADS * SWA_HEAD_DIM, SWA_WIDTH,
            3 * HY_WIDTH, HY_WIDTH)
IN_COLS = sum(IN_SIZES)
IN_SPLITS = tuple(int(s) for s in np.cumsum(IN_SIZES)[:-1])

kernel_name = "hybrid_mla_swa_hyena_dit"


def rmsnorm(x, g):
    xf = x.astype(jnp.float32)
    y = xf * lax.rsqrt(jnp.mean(xf * xf, axis=-1, keepdims=True) + NORM_EPS)
    return (y * g.astype(jnp.float32)).astype(x.dtype)


def axial_rope(num_tokens, rot_dim):
    rows = num_tokens // GRID_W
    row = jnp.repeat(jnp.arange(rows, dtype=jnp.float32), GRID_W)
    col = jnp.tile(jnp.arange(GRID_W, dtype=jnp.float32), rows)
    n_freq = rot_dim // 4
    freqs = ROPE_THETA ** (-jnp.arange(n_freq, dtype=jnp.float32) / n_freq)
    ang = jnp.concatenate([row[:, None] * freqs, col[:, None] * freqs], axis=-1)
    return jnp.cos(ang), jnp.sin(ang)


def apply_rope(x, rope):
    cos, sin = rope
    cos = cos[:, None, :].astype(x.dtype)
    sin = sin[:, None, :].astype(x.dtype)
    x1, x2 = jnp.split(x, 2, axis=-1)
    return jnp.concatenate([x1 * cos - x2 * sin, x2 * cos + x1 * sin], axis=-1)


def modulate_project(x, mod, norm_g, w_in):
    shift, scale, gate = jnp.split(mod, 3, axis=-1)
    h = rmsnorm(x, norm_g) * (1.0 + scale) + shift
    return h @ w_in, gate


def dense_attention(q, k, v, scale):
    s = jnp.einsum("bqhd,bkhd->bhqk", q, k).astype(jnp.float32) * scale
    p = jax.nn.softmax(s, axis=-1).astype(v.dtype)
    return jnp.einsum("bhqk,bkhd->bqhd", p, v)


def blocked_attention(q, k, v, scale):
    B, L, H, dk = q.shape
    qb = q.reshape(B, L // Q_BLOCK, Q_BLOCK, H, dk).transpose(1, 0, 2, 3, 4)
    out = lax.map(lambda qi: dense_attention(qi, k, v, scale), qb)
    return out.transpose(1, 0, 2, 3, 4).reshape(B, L, H, v.shape[-1])


def mla_queries(q_lat, lp, rope):
    B, L, _ = q_lat.shape
    q = (rmsnorm(q_lat, lp["mla_q_norm"]) @ lp["mla_w_uq"]).reshape(B, L, MLA_HEADS, MLA_QK_DIM)
    q_nope, q_rope = jnp.split(q, [MLA_NOPE_DIM], axis=-1)
    if rope is not None:
        q_rope = apply_rope(q_rope, rope)
    return jnp.concatenate([q_nope, q_rope], axis=-1)


def mla_keys_values(kv_lat, k_r, lp, rope):
    B, L, _ = kv_lat.shape
    kv = (rmsnorm(kv_lat, lp["mla_kv_norm"]) @ lp["mla_w_ukv"]).reshape(B, L, MLA_HEADS, MLA_NOPE_DIM + MLA_V_DIM)
    k_nope, v = jnp.split(kv, [MLA_NOPE_DIM], axis=-1)
    k_rope = k_r[:, :, None, :]
    if rope is not None:
        k_rope = apply_rope(k_rope, rope)
    k_rope = jnp.broadcast_to(k_rope, (B, L, MLA_HEADS, MLA_ROPE_DIM))
    return jnp.concatenate([k_nope, k_rope], axis=-1), v


def swa_latent(q, k, v, k_ctx, v_ctx, sink):
    f32 = jnp.float32
    B, L = q.shape[:2]
    nb = L // SWA_BLOCK
    qb = q.reshape(B, nb, SWA_BLOCK, SWA_KV_HEADS, SWA_GROUP, SWA_HEAD_DIM)
    pad = ((0, 0), (SWA_WINDOW, SWA_WINDOW), (0, 0), (0, 0))
    kp, vp = jnp.pad(k, pad), jnp.pad(v, pad)
    idx = jnp.arange(nb)[:, None] * SWA_BLOCK + jnp.arange(SWA_BAND)[None, :]
    kb, vb = kp[:, idx], vp[:, idx]
    kpos = idx - SWA_WINDOW
    qpos = jnp.arange(nb)[:, None] * SWA_BLOCK + jnp.arange(SWA_BLOCK)[None, :]
    diff = kpos[:, None, :] - qpos[:, :, None]
    valid = (jnp.abs(diff) <= SWA_WINDOW) & (kpos[:, None, :] >= 0) & (kpos[:, None, :] < L)
    scale = SWA_HEAD_DIM ** -0.5
    s_loc = jnp.einsum("bnqgrd,bnkgd->bngrqk", qb, kb).astype(f32) * scale
    s_loc = jnp.where(valid[None, :, None, None], s_loc, -jnp.inf)
    s_ctx = jnp.einsum("bnqgrd,bcgd->bngrqc", qb, k_ctx).astype(f32) * scale
    sink_g = sink.astype(f32).reshape(SWA_KV_HEADS, SWA_GROUP)[None, None, :, :, None, None]
    m = jnp.maximum(jnp.maximum(s_loc.max(-1, keepdims=True), s_ctx.max(-1, keepdims=True)), sink_g)
    p_loc = jnp.exp(s_loc - m)
    p_ctx = jnp.exp(s_ctx - m)
    denom = p_loc.sum(-1, keepdims=True) + p_ctx.sum(-1, keepdims=True) + jnp.exp(sink_g - m)
    o = (jnp.einsum("bngrqk,bnkgd->bnqgrd", (p_loc / denom).astype(v.dtype), vb)
         + jnp.einsum("bngrqc,bcgd->bnqgrd", (p_ctx / denom).astype(v.dtype), v_ctx))
    return o.reshape(B, L, SWA_HEADS, SWA_HEAD_DIM)


def swa_context(q, k, v, sink):
    f32 = jnp.float32
    B, C = q.shape[:2]
    qg = q.reshape(B, C, SWA_KV_HEADS, SWA_GROUP, SWA_HEAD_DIM)
    s = jnp.einsum("bqgrd,bkgd->bgrqk", qg, k).astype(f32) * SWA_HEAD_DIM ** -0.5
    sink_col = jnp.broadcast_to(sink.astype(f32).reshape(1, SWA_KV_HEADS, SWA_GROUP, 1, 1), s.shape[:-1] + (1,))
    p = jax.nn.softmax(jnp.concatenate([s, sink_col], axis=-1), axis=-1)[..., :-1]
    o = jnp.einsum("bgrqk,bkgd->bqgrd", p.astype(v.dtype), v)
    return o.reshape(B, C, SWA_HEADS, SWA_HEAD_DIM)


def short_conv(u, w, b):
    up = jnp.pad(u, ((0, 0), (1, 1), (0, 0)))
    return up[:, :-2] * w[0] + up[:, 1:-1] * w[1] + up[:, 2:] * w[2] + b


def hyena_filter(num_tokens, lp):
    f32 = jnp.float32
    t = jnp.linspace(0.0, 1.0, num_tokens, dtype=f32)[:, None]
    w = (2.0 * math.pi / num_tokens) * jnp.arange(num_tokens, dtype=f32)[:, None]
    bands = jnp.linspace(1e-4, HY_BANDS - 1, HY_BANDS, dtype=f32)[None, :]
    z = jnp.concatenate([t, jnp.cos(bands * w), -jnp.sin(bands * w)], axis=-1)
    freq = lp["hy_freq"].astype(f32)
    h = jnp.sin(freq * (z @ lp["hy_w1"].astype(f32) + lp["hy_b1"].astype(f32)))
    h = jnp.sin(freq * (h @ lp["hy_w2"].astype(f32) + lp["hy_b2"].astype(f32)))
    h = h @ lp["hy_w3"].astype(f32) + lp["hy_b3"].astype(f32)
    deltas = jnp.abs(jnp.linspace(HY_DECAY_FAST, HY_DECAY_SLOW, HY_WIDTH, dtype=f32))
    decay = jnp.exp(-t * deltas)
    h = h.reshape(num_tokens, 2, HY_WIDTH) * decay[:, None, :]
    kern = jnp.concatenate([h[:, 0], jnp.zeros((1, HY_WIDTH), f32), h[:0:-1, 1]], axis=0)
    return kern / (jnp.sum(jnp.abs(kern), axis=0, keepdims=True) + NORM_EPS)


def fft_long_conv(z, kern):
    L = z.shape[1]
    zf = jnp.fft.rfft(z.astype(jnp.float32), n=2 * L, axis=1)
    kf = jnp.fft.rfft(kern, n=2 * L, axis=0)
    y = jnp.fft.irfft(zf * kf[None], n=2 * L, axis=1)[:, :L]
    return y.astype(z.dtype)


def hyena_mix(u, lp):
    uc = short_conv(u, lp["hy_conv_w"], lp["hy_conv_b"])
    x0, x1, v = jnp.split(uc, 3, axis=-1)
    kern = hyena_filter(u.shape[1], lp)
    z = v * x1
    return x0 * (fft_long_conv(z, kern) + lp["hy_bias"] * z)


def merge_branches(o_a, o_b, o_h, g_a, g_b, g_h, w_out):
    B, L = o_a.shape[:2]
    y = jnp.concatenate([o_a.reshape(B, L, MLA_WIDTH) * jax.nn.silu(g_a),
                         o_b.reshape(B, L, SWA_WIDTH) * jax.nn.silu(g_b),
                         o_h * jax.nn.silu(g_h)], axis=-1)
    return y @ w_out


def hybrid_layer(x, xc, c, c_ctx, lp, update_ctx):
    B, L, _ = x.shape
    mod_x = (jax.nn.silu(c) @ lp["mod_w"] + lp["mod_b"])[:, None, :]
    mod_c = (jax.nn.silu(c_ctx) @ lp["mod_w"] + lp["mod_b"])[None, None, :]
    px, gate_x = modulate_project(x, mod_x, lp["norm_g"], lp["w_in"])
    pc, gate_c = modulate_project(xc, mod_c, lp["norm_g"], lp["w_in"])
    mq_x, mkv_x, mkr_x, mg_x, sq_x, sk_x, sv_x, sg_x, hu_x, hg_x = jnp.split(px, IN_SPLITS, axis=-1)
    mq_c, mkv_c, mkr_c, mg_c, sq_c, sk_c, sv_c, sg_c, hu_c, hg_c = jnp.split(pc, IN_SPLITS, axis=-1)
    C = xc.shape[1]
    rope_mla = axial_rope(L, MLA_ROPE_DIM)
    rope_swa = axial_rope(L, SWA_HEAD_DIM)

    k_a, v_a = mla_keys_values(mkv_x, mkr_x, lp, rope_mla)
    kc_a, vc_a = mla_keys_values(mkv_c, mkr_c, lp, None)
    q_a = mla_queries(mq_x, lp, rope_mla)
    o_a = blocked_attention(q_a, jnp.concatenate([k_a, kc_a], axis=1),
                            jnp.concatenate([v_a, vc_a], axis=1), MLA_QK_DIM ** -0.5)

    q_b = apply_rope(sq_x.reshape(B, L, SWA_HEADS, SWA_HEAD_DIM), rope_swa)
    k_b = apply_rope(sk_x.reshape(B, L, SWA_KV_HEADS, SWA_HEAD_DIM), rope_swa)
    v_b = sv_x.reshape(B, L, SWA_KV_HEADS, SWA_HEAD_DIM)
    kc_b = sk_c.reshape(B, C, SWA_KV_HEADS, SWA_HEAD_DIM)
    vc_b = sv_c.reshape(B, C, SWA_KV_HEADS, SWA_HEAD_DIM)
    o_b = swa_latent(q_b, k_b, v_b, kc_b, vc_b, lp["swa_sink"])

    o_h = hyena_mix(hu_x, lp)

    x_new = x + gate_x * merge_branches(o_a, o_b, o_h, mg_x, sg_x, hg_x, lp["w_out"])

    if update_ctx:
        oc_a = dense_attention(mla_queries(mq_c, lp, None), kc_a, vc_a, MLA_QK_DIM ** -0.5)
        oc_b = swa_context(sq_c.reshape(B, C, SWA_HEADS, SWA_HEAD_DIM), kc_b, vc_b, lp["swa_sink"])
        oc_h = hyena_mix(hu_c, lp)
        xc = xc + gate_c * merge_branches(oc_a, oc_b, oc_h, mg_c, sg_c, hg_c, lp["w_out"])
    return x_new, xc


def setup_inputs(seed: int = 0) -> dict:
    key = jax.random.key(seed)
    ks = jax.random.split(key, 32)
    f32 = jnp.float32

    def nrm(k, shape, scale):
        return jax.random.normal(k, shape, f32) * scale

    D = D_MODEL
    return {
        "x": nrm(ks[0], (BATCH, SEQ, D), 1.0),
        "c": nrm(ks[1], (BATCH, D), 1.0),
        "ctx": nrm(ks[2], (BATCH, CTX_LEN, D), 1.0),
        "c_ctx": nrm(ks[3], (D,), 1.0),
        "norm_g": 1.0 + nrm(ks[4], (DEPTH, D), 0.05),
        "mod_w": nrm(ks[5], (DEPTH, D, 3 * D), 0.5 * D ** -0.5),
        "mod_b": nrm(ks[6], (DEPTH, 3 * D), 0.02),
        "w_in": nrm(ks[7], (DEPTH, D, IN_COLS), D ** -0.5),
        "mla_q_norm": 1.0 + nrm(ks[8], (DEPTH, MLA_Q_RANK), 0.05),
        "mla_w_uq": nrm(ks[9], (DEPTH, MLA_Q_RANK, MLA_HEADS * MLA_QK_DIM), MLA_Q_RANK ** -0.5),
        "mla_kv_norm": 1.0 + nrm(ks[10], (DEPTH, MLA_KV_RANK), 0.05),
        "mla_w_ukv": nrm(ks[11], (DEPTH, MLA_KV_RANK, MLA_HEADS * (MLA_NOPE_DIM + MLA_V_DIM)), MLA_KV_RANK ** -0.5),
        "swa_sink": nrm(ks[12], (DEPTH, SWA_HEADS), 0.5),
        "hy_conv_w": nrm(ks[13], (DEPTH, HY_SHORT, 3 * HY_WIDTH), HY_SHORT ** -0.5),
        "hy_conv_b": nrm(ks[14], (DEPTH, 3 * HY_WIDTH), 0.02),
        "hy_w1": nrm(ks[15], (DEPTH, HY_EMB, HY_HIDDEN), HY_EMB ** -0.5),
        "hy_b1": nrm(ks[16], (DEPTH, HY_HIDDEN), 0.02),
        "hy_freq": 1.0 + nrm(ks[17], (DEPTH, HY_HIDDEN), 0.05),
        "hy_w2": nrm(ks[18], (DEPTH, HY_HIDDEN, HY_HIDDEN), HY_HIDDEN ** -0.5),
        "hy_b2": nrm(ks[19], (DEPTH, HY_HIDDEN), 0.02),
        "hy_w3": nrm(ks[20], (DEPTH, HY_HIDDEN, 2 * HY_WIDTH), HY_HIDDEN ** -0.5),
        "hy_b3": nrm(ks[21], (DEPTH, 2 * HY_WIDTH), 0.02),
        "hy_bias": nrm(ks[22], (DEPTH, HY_WIDTH), 0.5),
        "w_out": nrm(ks[23], (DEPTH, D_MIX, D), D_MIX ** -0.5),
        "final_norm_g": 1.0 + nrm(ks[24], (D,), 0.05),
    }


def reference(x, c, ctx, c_ctx, norm_g, mod_w, mod_b, w_in, mla_q_norm, mla_w_uq, mla_kv_norm, mla_w_ukv,
              swa_sink, hy_conv_w, hy_conv_b, hy_w1, hy_b1, hy_freq, hy_w2, hy_b2, hy_w3, hy_b3, hy_bias,
              w_out, final_norm_g):
    xc = ctx
    for l in range(DEPTH):
        lp = {
            "norm_g": norm_g[l], "mod_w": mod_w[l], "mod_b": mod_b[l], "w_in": w_in[l],
            "mla_q_norm": mla_q_norm[l], "mla_w_uq": mla_w_uq[l],
            "mla_kv_norm": mla_kv_norm[l], "mla_w_ukv": mla_w_ukv[l],
            "swa_sink": swa_sink[l],
            "hy_conv_w": hy_conv_w[l], "hy_conv_b": hy_conv_b[l],
            "hy_w1": hy_w1[l], "hy_b1": hy_b1[l], "hy_freq": hy_freq[l],
            "hy_w2": hy_w2[l], "hy_b2": hy_b2[l], "hy_w3": hy_w3[l], "hy_b3": hy_b3[l],
            "hy_bias": hy_bias[l], "w_out": w_out[l],
        }
        x, xc = hybrid_layer(x, xc, c, c_ctx, lp, update_ctx=(l < DEPTH - 1))
    return rmsnorm(x, final_norm_g)
```

```cpp
#include <hip/hip_runtime.h>
#include <hip/hip_cooperative_groups.h>
#include <cstdint>
#include <cstdio>
namespace cg = cooperative_groups;

typedef unsigned short bf16_t;
using bf16x8 = __attribute__((ext_vector_type(8))) short;
using f32x16 = __attribute__((ext_vector_type(16))) float;
using f32x4  = __attribute__((ext_vector_type(4))) float;
using u32x4  = __attribute__((ext_vector_type(4))) unsigned;
using u32x2  = __attribute__((ext_vector_type(2))) unsigned;
#define DEVI __device__ __forceinline__

constexpr int NB = 4, L = 8192, CT = 256, DM = 1024;
constexpr int TL = NB * L, TC = NB * CT, TA = TL + TC;
constexpr int PXW = 2080;
constexpr int NIN = 3200;
constexpr int LK = 8448, LKS = 8704;
constexpr int C_MQ = 0, C_MKV = 384, C_MKR = 640, C_MG = 672, C_SQ = 1056, C_SK = 1440, C_SV = 1568, C_SG = 1696;
constexpr float EPS = 1e-6f;
constexpr int NFFT = 16384;

constexpr size_t al256(size_t x) { return (x + 255) / 256 * 256; }
constexpr size_t OFF_WIN  = 0;
constexpr size_t OFF_WUQ  = OFF_WIN  + al256((size_t)2 * NIN * 1024 * 2);
constexpr size_t OFF_WUKV = OFF_WUQ  + al256((size_t)2 * 576 * 384 * 2);
constexpr size_t OFF_WOUT = OFF_WUKV + al256((size_t)2 * 768 * 256 * 2);
constexpr size_t OFF_MOD  = OFF_WOUT + al256((size_t)2 * 1024 * 1024 * 2);
constexpr size_t OFF_TW   = OFF_MOD  + al256((size_t)2 * 5 * 3072 * 4);
constexpr size_t OFF_PSUM = OFF_TW   + al256((size_t)8192 * 8);
constexpr size_t OFF_HKC  = OFF_PSUM + al256((size_t)2 * 512 * 512 * 4);
constexpr size_t OFF_XC   = OFF_HKC  + al256((size_t)512 * 256 * 4);
constexpr size_t OFF_RPM  = OFF_XC   + al256((size_t)TC * 1024 * 4);
constexpr size_t OFF_RPS  = OFF_RPM  + al256((size_t)L * 16 * 8);
constexpr size_t OFF_KF   = OFF_RPS  + al256((size_t)L * 32 * 8);
constexpr size_t OFF_H    = OFF_KF   + al256((size_t)2 * 256 * NFFT * 8);
constexpr size_t OFF_PX   = OFF_H    + al256((size_t)TA * 1024 * 2);
constexpr size_t OFF_HT   = OFF_PX   + al256((size_t)TA * PXW * 2);
constexpr size_t OFF_HTC  = OFF_HT   + al256((size_t)NB * 1024 * L * 2);
constexpr size_t OFF_QA   = OFF_HTC  + al256((size_t)NB * 1024 * CT * 2);
constexpr size_t OFF_KA   = OFF_QA   + al256((size_t)NB * 6 * LK * 96 * 2);
constexpr size_t OFF_VTA  = OFF_KA   + al256((size_t)NB * 6 * LK * 96 * 2);
constexpr size_t OFF_KS   = OFF_VTA  + al256((size_t)NB * 6 * 64 * LK * 2);
constexpr size_t OFF_VS   = OFF_KS   + al256((size_t)NB * 2 * LKS * 64 * 2);
constexpr size_t OFF_BAR  = OFF_VS   + al256((size_t)NB * 2 * LKS * 64 * 2);
constexpr size_t OFF_YHT  = OFF_BAR  + 4096;
constexpr size_t OFF_YHTC = OFF_YHT  + al256((size_t)NB * 256 * L * 2);
constexpr size_t WS_END   = OFF_YHTC + al256((size_t)NB * 256 * CT * 2);
constexpr size_t OFF_Y = OFF_H;
constexpr size_t OFF_HKT = OFF_PX;

struct P {
  const float *x, *c, *ctx, *c_ctx, *norm_g, *mod_w, *mod_b, *w_in, *q_norm, *w_uq, *kv_norm, *w_ukv, *sink, *conv_w, *conv_b,
              *hw1, *hb1, *hfreq, *hw2, *hb2, *hw3, *hb3, *hbias, *w_out, *fnorm;
  float* out; char* ws;
};

typedef __bf16 bf16n2 __attribute__((ext_vector_type(2)));
typedef float f32x2 __attribute__((ext_vector_type(2)));
DEVI unsigned cvtpk(float lo, float hi) { f32x2 v = {lo, hi}; bf16n2 r = __builtin_convertvector(v, bf16n2); return __builtin_bit_cast(unsigned, r); }
DEVI float bf2f(bf16_t v) { return __uint_as_float((unsigned)v << 16); }
DEVI bf16_t f2bf(float f) { return (bf16_t)(cvtpk(f, f) & 0xffffu); }
DEVI float blo(unsigned w) { return __uint_as_float(w << 16); }
DEVI float bhi(unsigned w) { return __uint_as_float(w & 0xffff0000u); }
DEVI int crow(int r, int hi) { return (r & 3) + 8 * (r >> 2) + 4 * hi; }
DEVI float silu(float g) { return g / (1.f + __expf(-g)); }
DEVI int swz128(int row, int chunk) { return row * 128 + ((chunk ^ ((row >> 1) & 7)) << 4); }
DEVI float wave_sum(float v) { for (int o = 32; o > 0; o >>= 1) v += __shfl_xor(v, o); return v; }

struct GArgs { const bf16_t* A; int lda; const bf16_t* Bt; int K; int nB; const bf16_t* At; int ldt; };
template <int AMODE, bool NORM, bool SWAP, class Epi>
DEVI void gemm_tile(char* lds, const GArgs& g, int m0, int n0, const Epi& epi) {
  int tid_ = threadIdx.x; asm volatile("" : "+v"(tid_));
  const int tid = tid_, wid = tid >> 6, lane = tid & 63, r32 = lane & 31, hi = lane >> 5;
  const int wm = wid & 3, wn = wid >> 2;
  char* sA = lds; char* sB = lds + 65536; float* rs = (float*)(lds + 98304);
  f32x16 acc[2][2];
#pragma unroll
  for (int i = 0; i < 2; ++i)
#pragma unroll
    for (int j = 0; j < 2; ++j)
#pragma unroll
      for (int r = 0; r < 16; ++r) acc[i][j][r] = 0.f;
  const int KT = g.K >> 6;
  const int srow = tid >> 3, sch = tid & 7;
  u32x4 Xa0, Xa1, Xa2, Xa3, Xb0, Xb1, Ya0, Ya1, Ya2, Ya3, Yb0, Yb1;
  float ss0 = 0.f, ss1 = 0.f, ss2 = 0.f, ss3 = 0.f;
  const u32x4 zero4 = {0u, 0u, 0u, 0u};
#define G_LOAD(S, kt) do { { const bf16_t* s_ = g.A + (size_t)(m0 + srow) * g.lda + (kt) * 64 + sch * 8; \
      S##a0 = *(const u32x4*)(s_); S##a1 = *(const u32x4*)(s_ + (size_t)64 * g.lda); S##a2 = *(const u32x4*)(s_ + (size_t)128 * g.lda); S##a3 = *(const u32x4*)(s_ + (size_t)192 * g.lda); } \
    { const int n_ = n0 + srow; const bf16_t* s_ = g.Bt + (size_t)n_ * g.K + (kt) * 64 + sch * 8; \
      S##b0 = (n_ < g.nB) ? *(const u32x4*)(s_) : zero4; S##b1 = (n_ + 64 < g.nB) ? *(const u32x4*)(s_ + (size_t)64 * g.K) : zero4; } } while (0)
#define SSQ(acc_, v_) do { _Pragma("unroll") for (int q_ = 0; q_ < 4; ++q_) { float a_ = blo(v_[q_]), b_ = bhi(v_[q_]); acc_ += a_ * a_ + b_ * b_; } } while (0)
#define G_WRITE(S, buf) do { char* a_ = sA + (buf) * 32768; char* b_ = sB + (buf) * 16384; \
    *(u32x4*)(a_ + swz128(srow, sch)) = S##a0; *(u32x4*)(a_ + swz128(srow + 64, sch)) = S##a1; *(u32x4*)(a_ + swz128(srow + 128, sch)) = S##a2; *(u32x4*)(a_ + swz128(srow + 192, sch)) = S##a3; \
    if (NORM) { SSQ(ss0, S##a0); SSQ(ss1, S##a1); SSQ(ss2, S##a2); SSQ(ss3, S##a3); } \
    *(u32x4*)(b_ + swz128(srow, sch)) = S##b0; *(u32x4*)(b_ + swz128(srow + 64, sch)) = S##b1; } while (0)
#define G_COMPUTE(buf) do { const char* a_ = sA + (buf) * 32768; const char* b_ = sB + (buf) * 16384; \
    _Pragma("unroll") for (int kk = 0; kk < 4; ++kk) { bf16x8 af[2], bfr[2]; \
      _Pragma("unroll") for (int mi = 0; mi < 2; ++mi) af[mi] = *(const bf16x8*)(a_ + swz128(wm * 64 + mi * 32 + r32, kk * 2 + hi)); \
      _Pragma("unroll") for (int ni = 0; ni < 2; ++ni) bfr[ni] = *(const bf16x8*)(b_ + swz128(wn * 64 + ni * 32 + r32, kk * 2 + hi)); \
      _Pragma("unroll") for (int mi = 0; mi < 2; ++mi) _Pragma("unroll") for (int ni = 0; ni < 2; ++ni) \
          acc[mi][ni] = SWAP ? __builtin_amdgcn_mfma_f32_32x32x16_bf16(bfr[ni], af[mi], acc[mi][ni], 0, 0, 0) \
                             : __builtin_amdgcn_mfma_f32_32x32x16_bf16(af[mi], bfr[ni], acc[mi][ni], 0, 0, 0); } } while (0)
  f32x4 xp[8];
  if constexpr (AMODE == 2) {
    static_assert(!NORM, "the DMA path does not see the operands in registers");
    asm volatile("s_waitcnt vmcnt(0)" ::: "memory");
    const int gch = sch ^ ((srow >> 1) & 7);
    const bf16_t* gA = g.A + (size_t)(m0 + srow) * g.lda + gch * 8;
    int nb0 = n0 + srow, nb1 = n0 + srow + 64; nb0 = nb0 < g.nB ? nb0 : g.nB - 1; nb1 = nb1 < g.nB ? nb1 : g.nB - 1;
    const bf16_t* gB0 = g.Bt + (size_t)nb0 * g.K + gch * 8; const bf16_t* gB1 = g.Bt + (size_t)nb1 * g.K + gch * 8;
    const int wv = __builtin_amdgcn_readfirstlane(wid);
    char* dA = lds + wv * 1024; char* dB = lds + 98304 + wv * 1024;
#define GLDS(kt, b) do { const int ko_ = (kt) * 64; char* a_ = dA + (b) * 32768; char* b_ = dB + (b) * 16384; \
      __builtin_amdgcn_global_load_lds((const unsigned*)(gA + ko_), (unsigned*)(a_), 16, 0, 0); \
      __builtin_amdgcn_global_load_lds((const unsigned*)(gA + (size_t)64 * g.lda + ko_), (unsigned*)(a_ + 8192), 16, 0, 0); \
      __builtin_amdgcn_global_load_lds((const unsigned*)(gA + (size_t)128 * g.lda + ko_), (unsigned*)(a_ + 16384), 16, 0, 0); \
      __builtin_amdgcn_global_load_lds((const unsigned*)(gA + (size_t)192 * g.lda + ko_), (unsigned*)(a_ + 24576), 16, 0, 0); \
      __builtin_amdgcn_global_load_lds((const unsigned*)(gB0 + ko_), (unsigned*)(b_), 16, 0, 0); \
      __builtin_amdgcn_global_load_lds((const unsigned*)(gB1 + ko_), (unsigned*)(b_ + 8192), 16, 0, 0); } while (0)
    GLDS(0, 0); GLDS(1, 1);
    int buf = 0, wbuf = 2; const int KP = KT - 8;
    for (int kt = 0; kt < KT; ++kt) {
      if (kt + 1 >= KT) asm volatile("s_waitcnt vmcnt(0)" ::: "memory");
      else if (Epi::PRE && (kt == KP + 1 || kt == KP + 2)) asm volatile("s_waitcnt vmcnt(14)" ::: "memory");
      else asm volatile("s_waitcnt vmcnt(6)" ::: "memory");
      asm volatile("s_waitcnt lgkmcnt(0)" ::: "memory"); __builtin_amdgcn_s_barrier();
      if (kt + 2 < KT) GLDS(kt + 2, wbuf);
      if constexpr (Epi::PRE) { if (kt == KP) epi.pre(xp, m0, n0, wm, wn, r32, hi); }
      { const char* a_ = lds + buf * 32768; const char* b_ = lds + 98304 + buf * 16384;
#pragma unroll
        for (int kk = 0; kk < 4; ++kk) { bf16x8 af[2], bfr[2];
#pragma unroll
          for (int mi = 0; mi < 2; ++mi) af[mi] = *(const bf16x8*)(a_ + swz128(wm * 64 + mi * 32 + r32, kk * 2 + hi));
#pragma unroll
          for (int ni = 0; ni < 2; ++ni) bfr[ni] = *(const bf16x8*)(b_ + swz128(wn * 64 + ni * 32 + r32, kk * 2 + hi));
#pragma unroll
          for (int mi = 0; mi < 2; ++mi)
#pragma unroll
            for (int ni = 0; ni < 2; ++ni)
              acc[mi][ni] = SWAP ? __builtin_amdgcn_mfma_f32_32x32x16_bf16(bfr[ni], af[mi], acc[mi][ni], 0, 0, 0)
                                 : __builtin_amdgcn_mfma_f32_32x32x16_bf16(af[mi], bfr[ni], acc[mi][ni], 0, 0, 0); } }
      buf = buf == 2 ? 0 : buf + 1; wbuf = wbuf == 2 ? 0 : wbuf + 1;
    }
#undef GLDS
    epi.template run<SWAP>(acc, m0, n0, wm, wn, r32, hi, rs, xp);
    __syncthreads();
    return;
  }
  G_LOAD(X, 0); G_LOAD(Y, 1); G_WRITE(X, 0); __syncthreads();
  for (int kt = 0; kt < KT; kt += 2) {
    if constexpr (Epi::PRE) { if (kt == KT - 8) epi.pre(xp, m0, n0, wm, wn, r32, hi); }
    if (kt + 2 < KT) G_LOAD(X, kt + 2);
    G_COMPUTE(0);
    G_WRITE(Y, 1);
    __syncthreads();
    if (kt + 3 < KT) G_LOAD(Y, kt + 3);
    G_COMPUTE(1);
    if (kt + 2 < KT) { G_WRITE(X, 0); }
    __syncthreads();
  }
  if (NORM) {
    ss0 += __shfl_xor(ss0, 1); ss0 += __shfl_xor(ss0, 2); ss0 += __shfl_xor(ss0, 4);
    ss1 += __shfl_xor(ss1, 1); ss1 += __shfl_xor(ss1, 2); ss1 += __shfl_xor(ss1, 4);
    ss2 += __shfl_xor(ss2, 1); ss2 += __shfl_xor(ss2, 2); ss2 += __shfl_xor(ss2, 4);
    ss3 += __shfl_xor(ss3, 1); ss3 += __shfl_xor(ss3, 2); ss3 += __shfl_xor(ss3, 4);
    if (sch == 0) { const float ik = 1.f / (float)g.K;
      rs[srow] = rsqrtf(ss0 * ik + EPS); rs[srow + 64] = rsqrtf(ss1 * ik + EPS); rs[srow + 128] = rsqrtf(ss2 * ik + EPS); rs[srow + 192] = rsqrtf(ss3 * ik + EPS); }
    __syncthreads();
  }
  epi.template run<SWAP>(acc, m0, n0, wm, wn, r32, hi, rs, xp);
  __syncthreads();
#undef G_LOAD
#undef SSQ
#undef G_WRITE
#undef G_COMPUTE
}
DEVI u32x2 pack4(float a, float b, float c, float d) { u32x2 w; w.x = cvtpk(a, b); w.y = cvtpk(c, d); return w; }

struct EpiIn {
  static constexpr bool PRE = false;
  bf16_t* px; bf16_t* ht; bf16_t* htc;
  template <bool SWAP> DEVI void run(const f32x16 (&acc)[2][2], int m0, int n0, int wm, int wn, int r32, int hi, const float*, const f32x4 (&)[8]) const {
#pragma unroll
    for (int mi = 0; mi < 2; ++mi)
#pragma unroll
      for (int ni = 0; ni < 2; ++ni)
#pragma unroll
        for (int q = 0; q < 4; ++q) {
          const u32x2 w = pack4(acc[mi][ni][4 * q], acc[mi][ni][4 * q + 1], acc[mi][ni][4 * q + 2], acc[mi][ni][4 * q + 3]);
          if (SWAP) { const int m = m0 + wm * 64 + mi * 32 + r32, nb = n0 + wn * 64 + ni * 32 + 8 * q + 4 * hi;
            if (nb < PXW) *(u32x2*)(px + (size_t)m * PXW + nb) = w;
          } else { const int ch = n0 + wn * 64 + ni * 32 + r32 - 2176, mb = m0 + wm * 64 + mi * 32 + 8 * q + 4 * hi;
            if (mb < TL) { const int b = mb >> 13, t = mb & (L - 1); *(u32x2*)(ht + ((size_t)(b * 1024 + ch)) * L + t) = w; }
            else { const int j = mb - TL, b = j >> 8, t = j & 255; *(u32x2*)(htc + ((size_t)(b * 1024 + ch)) * CT + t) = w; } }
        }
  }
};
DEVI void row_to_bk(int m, int& b, int& krow) { if (m < TL) { b = m >> 13; krow = m & (L - 1); } else { const int j = m - TL; b = j >> 8; krow = L + (j & 255); } }
struct EpiQ {
  static constexpr bool PRE = false;
  bf16_t* qa;
  template <bool SWAP> DEVI void run(const f32x16 (&acc)[2][2], int m0, int n0, int wm, int wn, int r32, int hi, const float* rs, const f32x4 (&)[8]) const {
#pragma unroll
    for (int mi = 0; mi < 2; ++mi) { const int ml = wm * 64 + mi * 32 + r32, m = m0 + ml; const float s = rs[ml]; int b, krow; row_to_bk(m, b, krow);
#pragma unroll
      for (int ni = 0; ni < 2; ++ni)
#pragma unroll
        for (int q = 0; q < 4; ++q) { const int nb = n0 + wn * 64 + ni * 32 + 8 * q + 4 * hi;
          if (nb < 576) { const int h = nb / 96, d = nb - h * 96;
            *(u32x2*)(qa + ((size_t)(b * 6 + h) * LK + krow) * 96 + d) = pack4(acc[mi][ni][4 * q] * s, acc[mi][ni][4 * q + 1] * s, acc[mi][ni][4 * q + 2] * s, acc[mi][ni][4 * q + 3] * s); } } }
  }
};
struct EpiKV {
  static constexpr bool PRE = false;
  bf16_t* ka; bf16_t* vta;
  template <bool SWAP> DEVI void run(const f32x16 (&acc)[2][2], int m0, int n0, int wm, int wn, int r32, int hi, const float* rs, const f32x4 (&)[8]) const {
#pragma unroll
    for (int mi = 0; mi < 2; ++mi)
#pragma unroll
      for (int ni = 0; ni < 2; ++ni)
#pragma unroll
        for (int q = 0; q < 4; ++q) {
          if (SWAP) { const int ml = wm * 64 + mi * 32 + r32; const float s = rs[ml]; int b, krow; row_to_bk(m0 + ml, b, krow);
            const int nb = n0 + wn * 64 + ni * 32 + 8 * q + 4 * hi, h = nb >> 6, d = nb & 63;
            *(u32x2*)(ka + ((size_t)(b * 6 + h) * LK + krow) * 96 + d) = pack4(acc[mi][ni][4 * q] * s, acc[mi][ni][4 * q + 1] * s, acc[mi][ni][4 * q + 2] * s, acc[mi][ni][4 * q + 3] * s);
          } else { const int nv = n0 + wn * 64 + ni * 32 + r32 - 384, h = nv >> 6, dv = nv & 63; const int mlb = wm * 64 + mi * 32 + 8 * q + 4 * hi; int b, krow; row_to_bk(m0 + mlb, b, krow);
            *(u32x2*)(vta + ((size_t)(b * 6 + h) * 64 + dv) * LK + krow) = pack4(acc[mi][ni][4 * q] * rs[mlb], acc[mi][ni][4 * q + 1] * rs[mlb + 1], acc[mi][ni][4 * q + 2] * rs[mlb + 2], acc[mi][ni][4 * q + 3] * rs[mlb + 3]); }
        }
  }
};
struct EpiOut {
  static constexpr bool PRE = true;
  const float* xl; const float* xc; float* dl; float* dc; const float* mod;
  DEVI void pre(f32x4 (&xp)[8], int m0, int n0, int wm, int wn, int r32, int hi) const {
    const int m = m0 + wm * 64 + r32; const float* src = m < TL ? xl + (size_t)m * DM : xc + (size_t)(m - TL) * DM;
#pragma unroll
    for (int ni = 0; ni < 2; ++ni)
#pragma unroll
      for (int q = 0; q < 4; ++q) xp[ni * 4 + q] = *(const f32x4*)(src + n0 + wn * 64 + ni * 32 + 8 * q + 4 * hi);
  }
  template <bool SWAP> DEVI void run(const f32x16 (&acc)[2][2], int m0, int n0, int wm, int wn, int r32, int hi, const float*, const f32x4 (&xp)[8]) const {
    f32x4 x1[8];
    { const int m = m0 + wm * 64 + 32 + r32; const float* src = m < TL ? xl + (size_t)m * DM : xc + (size_t)(m - TL) * DM;
#pragma unroll
      for (int ni = 0; ni < 2; ++ni)
#pragma unroll
        for (int q = 0; q < 4; ++q) x1[ni * 4 + q] = *(const f32x4*)(src + n0 + wn * 64 + ni * 32 + 8 * q + 4 * hi); }
#pragma unroll
    for (int mi = 0; mi < 2; ++mi) { const int m = m0 + wm * 64 + mi * 32 + r32;
      float* dst; int v;
      if (m < TL) { dst = dl + (size_t)m * DM; v = m >> 13; } else { dst = dc + (size_t)(m - TL) * DM; v = 4; }
      const float* gt = mod + v * 3072 + 2048;
#pragma unroll
      for (int ni = 0; ni < 2; ++ni)
#pragma unroll
        for (int q = 0; q < 4; ++q) { const int nb = n0 + wn * 64 + ni * 32 + 8 * q + 4 * hi;
          const f32x4 xv = mi == 0 ? xp[ni * 4 + q] : x1[ni * 4 + q], gv = *(const f32x4*)(gt + nb); f32x4 o;
          o[0] = xv[0] + gv[0] * acc[mi][ni][4 * q]; o[1] = xv[1] + gv[1] * acc[mi][ni][4 * q + 1]; o[2] = xv[2] + gv[2] * acc[mi][ni][4 * q + 2]; o[3] = xv[3] + gv[3] * acc[mi][ni][4 * q + 3];
          *(f32x4*)(dst + nb) = o; } }
  }
};

template <int DK> DEVI int kaddr(int row, int chunk) { return DK == 96 ? row * 208 + chunk * 16 : swz128(row, chunk); }
template <int DK> DEVI void qkt(f32x16& p0, f32x16& p1, const char* Ks, const bf16x8* qr, int r32, int hi, float init) {
#pragma unroll
  for (int r = 0; r < 16; ++r) { p0[r] = init; p1[r] = init; }
  constexpr int NQ = DK / 16;
  bf16x8 kf[2 * NQ];
#pragma unroll
  for (int d0 = 0; d0 < 2 && d0 < NQ; ++d0) { kf[2 * d0] = *(const bf16x8*)(Ks + kaddr<DK>(r32, d0 * 2 + hi)); kf[2 * d0 + 1] = *(const bf16x8*)(Ks + kaddr<DK>(32 + r32, d0 * 2 + hi)); }
  __builtin_amdgcn_sched_group_barrier(0x100, 4, 0);
#pragma unroll
  for (int d0 = 0; d0 < NQ; ++d0) {
    if (d0 + 2 < NQ) { kf[2 * (d0 + 2)] = *(const bf16x8*)(Ks + kaddr<DK>(r32, (d0 + 2) * 2 + hi)); kf[2 * (d0 + 2) + 1] = *(const bf16x8*)(Ks + kaddr<DK>(32 + r32, (d0 + 2) * 2 + hi)); }
    p0 = __builtin_amdgcn_mfma_f32_32x32x16_bf16(kf[2 * d0], qr[d0], p0, 0, 0, 0);
    p1 = __builtin_amdgcn_mfma_f32_32x32x16_bf16(kf[2 * d0 + 1], qr[d0], p1, 0, 0, 0);
    __builtin_amdgcn_sched_group_barrier(0x8, 2, 0);
    if (d0 + 2 < NQ) __builtin_amdgcn_sched_group_barrier(0x100, 2, 0);
  }
}
template <bool MASK, bool FIRST>
DEVI void partialSM(f32x16& p0, f32x16& p1, float& M, float& alpha, bool domask, int kp0, int qpos, int hi) {
  constexpr float THR2 = 11.541560327111707f;
  if (MASK) { if (domask) {
#pragma unroll
      for (int r = 0; r < 16; ++r) { const int k0 = kp0 + crow(r, hi), k1 = k0 + 32; int d0 = k0 - qpos, d1 = k1 - qpos; d0 = d0 < 0 ? -d0 : d0; d1 = d1 < 0 ? -d1 : d1;
        if (!(d0 <= 128 && (unsigned)k0 < (unsigned)L)) p0[r] = -1e30f;
        if (!(d1 <= 128 && (unsigned)k1 < (unsigned)L)) p1[r] = -1e30f; } } }
  float pmax = p0[0];
#pragma unroll
  for (int r = 1; r < 16; ++r) pmax = fmaxf(pmax, p0[r]);
#pragma unroll
  for (int r = 0; r < 16; ++r) pmax = fmaxf(pmax, p1[r]);
  { auto rr = __builtin_amdgcn_permlane32_swap(__float_as_uint(pmax), __float_as_uint(pmax), false, false);
    pmax = fmaxf(__uint_as_float(rr[0]), __uint_as_float(rr[1])); }
  if (FIRST) { const float Mn = fmaxf(M, pmax); alpha = __builtin_amdgcn_exp2f(M - Mn); M = Mn;
#pragma unroll
    for (int r = 0; r < 16; ++r) { p0[r] -= Mn; p1[r] -= Mn; }
  } else if (__builtin_expect(__all(pmax <= THR2), 1)) { alpha = 1.f; }
  else { const float d = fmaxf(pmax, 0.f); alpha = __builtin_amdgcn_exp2f(-d); M += d;
#pragma unroll
    for (int r = 0; r < 16; ++r) { p0[r] -= d; p1[r] -= d; } }
#pragma unroll
  for (int r = 0; r < 16; ++r) p0[r] = __builtin_amdgcn_exp2f(p0[r]);
}
DEVI void finishSM(f32x16& p0, f32x16& p1, bf16x8& pa0, bf16x8& pa1, bf16x8& pa2, bf16x8& pa3) {
#pragma unroll
  for (int r = 0; r < 16; ++r) p1[r] = __builtin_amdgcn_exp2f(p1[r]);
#define PK4(Pv, BASE, OUT) do { unsigned a0 = cvtpk(Pv[BASE + 0], Pv[BASE + 1]), a1 = cvtpk(Pv[BASE + 2], Pv[BASE + 3]);   \
    unsigned b0 = cvtpk(Pv[BASE + 4], Pv[BASE + 5]), b1 = cvtpk(Pv[BASE + 6], Pv[BASE + 7]);                              \
    auto r0 = __builtin_amdgcn_permlane32_swap(a0, b0, false, false); auto r1 = __builtin_amdgcn_permlane32_swap(a1, b1, false, false); \
    u32x4 w = {r0[0], r1[0], r0[1], r1[1]}; OUT = *reinterpret_cast<bf16x8*>(&w); } while (0)
  PK4(p0, 0, pa0); PK4(p0, 8, pa1); PK4(p1, 0, pa2); PK4(p1, 8, pa3);
#undef PK4
}
DEVI void pv(f32x16* o, const char* Vs, bf16x8 pa0, bf16x8 pa1, bf16x8 pa2, bf16x8 pa3, int r32, int hi) {
  bf16x8 va[4], vb[4];
#pragma unroll
  for (int ks = 0; ks < 4; ++ks) { va[ks] = *(const bf16x8*)(Vs + swz128(r32, 2 * ks + hi)); vb[ks] = *(const bf16x8*)(Vs + swz128(32 + r32, 2 * ks + hi)); }
  __builtin_amdgcn_sched_group_barrier(0x100, 8, 0);
  const bf16x8 ones = {(short)0x3F80, (short)0x3F80, (short)0x3F80, (short)0x3F80, (short)0x3F80, (short)0x3F80, (short)0x3F80, (short)0x3F80};
  o[2] = __builtin_amdgcn_mfma_f32_32x32x16_bf16(pa0, ones, o[2], 0, 0, 0);
  o[2] = __builtin_amdgcn_mfma_f32_32x32x16_bf16(pa1, ones, o[2], 0, 0, 0);
  o[2] = __builtin_amdgcn_mfma_f32_32x32x16_bf16(pa2, ones, o[2], 0, 0, 0);
  o[2] = __builtin_amdgcn_mfma_f32_32x32x16_bf16(pa3, ones, o[2], 0, 0, 0);
  __builtin_amdgcn_sched_group_barrier(0x8, 4, 0);
  o[0] = __builtin_amdgcn_mfma_f32_32x32x16_bf16(pa0, va[0], o[0], 0, 0, 0);
  o[1] = __builtin_amdgcn_mfma_f32_32x32x16_bf16(pa0, vb[0], o[1], 0, 0, 0);
  o[0] = __builtin_amdgcn_mfma_f32_32x32x16_bf16(pa1, va[1], o[0], 0, 0, 0);
  o[1] = __builtin_amdgcn_mfma_f32_32x32x16_bf16(pa1, vb[1], o[1], 0, 0, 0);
  o[0] = __builtin_amdgcn_mfma_f32_32x32x16_bf16(pa2, va[2], o[0], 0, 0, 0);
  o[1] = __builtin_amdgcn_mfma_f32_32x32x16_bf16(pa2, vb[2], o[1], 0, 0, 0);
  o[0] = __builtin_amdgcn_mfma_f32_32x32x16_bf16(pa3, va[3], o[0], 0, 0, 0);
  o[1] = __builtin_amdgcn_mfma_f32_32x32x16_bf16(pa3, vb[3], o[1], 0, 0, 0);
  __builtin_amdgcn_sched_group_barrier(0x8, 8, 0);
}
DEVI void rope8(bf16x8& a, bf16x8& b, const float2* __restrict__ cs) {
  u32x4 ua = *reinterpret_cast<u32x4*>(&a), ub = *reinterpret_cast<u32x4*>(&b);
#pragma unroll
  for (int q = 0; q < 4; ++q) {
    const f32x4 e = *(const f32x4*)(cs + 2 * q);
    const float x10 = blo(ua[q]), x11 = bhi(ua[q]), x20 = blo(ub[q]), x21 = bhi(ub[q]);
    ua[q] = cvtpk(x10 * e[0] - x20 * e[1], x11 * e[2] - x21 * e[3]);
    ub[q] = cvtpk(x20 * e[0] + x10 * e[1], x21 * e[2] + x11 * e[3]);
  }
  a = *reinterpret_cast<bf16x8*>(&ua); b = *reinterpret_cast<bf16x8*>(&ub);
}
template <int DK, bool MASK>
DEVI void attn_body(char* lds, const bf16_t* __restrict__ Qb, int ldq, const bf16_t* __restrict__ Kh, const bf16_t* __restrict__ Vth, int ldv,
                    int startA, int nA, int startB, int nB, float scale, float m_init, float l_init, int q0, const float2* __restrict__ ropetab,
                    const bf16_t* __restrict__ gate, bf16_t* __restrict__ Yo) {
  constexpr int NQ = DK / 16, CPR = DK / 8, KBUF = 13312, VBUF = 8192;
  int tid_ = threadIdx.x; asm volatile("" : "+v"(tid_));
  const int tid = tid_, wid = tid >> 6, lane = tid & 63, r32 = lane & 31, hi = lane >> 5;
  char* K_lds = lds; char* V_lds = lds + 4 * KBUF; float* wsf = (float*)(lds + 4 * KBUF + 4 * VBUF) + wid * 64; float* al_l = wsf + 32;
  const float C = scale * 1.4426950408889634f;
  float M = m_init * 1.4426950408889634f; f32x16 o[3]; bf16x8 qr[NQ];
#pragma unroll
  for (int r = 0; r < 16; ++r) { o[0][r] = 0.f; o[1][r] = 0.f; o[2][r] = l_init; }
  const int qpos = q0 + wid * 32 + r32;
  const int wv = __builtin_amdgcn_readfirstlane(wid);
  const bool n3 = (DK == 96) && (wv < 5);
  int kofsA, kofsB = 0;
  if (DK == 96) { const int sA = 64 * wv + lane, rA = sA / 13, cA = sA - rA * 13; kofsA = rA * 96 + (cA < 12 ? cA : 0) * 8;
                  const int sB = 64 * (wv + 8) + lane, rB = sB / 13, cB = sB - rB * 13; kofsB = (rB < 64 ? rB : 63) * 96 + (cB < 12 ? cB : 0) * 8; }
  else { const int r_ = 8 * wv + (lane >> 3), c_ = (lane & 7) ^ ((r_ >> 1) & 7); kofsA = r_ * 64 + c_ * 8; }
  size_t vofs; { const int r_ = 8 * wv + (lane >> 3), c_ = (lane & 7) ^ ((r_ >> 1) & 7); vofs = (size_t)r_ * ldv + c_ * 8; }
#define TROW(j) ((j) < nA ? startA + 64 * (j) : startB + 64 * ((j) - nA))
#define GLDS(j, slot) do { const int kr_ = TROW(j); const bf16_t* kb_ = Kh + (size_t)kr_ * DK; \
    __builtin_amdgcn_global_load_lds((const unsigned*)(kb_ + kofsA), (unsigned*)(K_lds + (slot) * KBUF + wv * 1024), 16, 0, 0); \
    if (n3) __builtin_amdgcn_global_load_lds((const unsigned*)(kb_ + kofsB), (unsigned*)(K_lds + (slot) * KBUF + (wv + 8) * 1024), 16, 0, 0); \
    __builtin_amdgcn_global_load_lds((const unsigned*)(Vth + vofs + kr_), (unsigned*)(V_lds + (slot) * VBUF + wv * 1024), 16, 0, 0); } while (0)
#define WAITT(more) do { if (more) { if (n3) asm volatile("s_waitcnt vmcnt(3)" ::: "memory"); else asm volatile("s_waitcnt vmcnt(2)" ::: "memory"); } \
    else asm volatile("s_waitcnt vmcnt(0)" ::: "memory"); \
    asm volatile("s_waitcnt lgkmcnt(0)" ::: "memory"); __builtin_amdgcn_s_barrier(); } while (0)
  GLDS(0, 0); GLDS(1, 1);
  { const bf16_t* Qw = Qb + (size_t)(wid * 32 + r32) * ldq + hi * 8;
#pragma unroll
    for (int d0 = 0; d0 < NQ; ++d0) qr[d0] = *(const bf16x8*)(Qw + d0 * 16);
    if (ropetab) {
      if (DK == 96) rope8(qr[NQ - 2], qr[NQ - 1], ropetab + (size_t)qpos * 16 + hi * 8);
      else { rope8(qr[0], qr[2], ropetab + (size_t)qpos * 32 + hi * 8); rope8(qr[1], qr[3], ropetab + (size_t)qpos * 32 + 16 + hi * 8); }
    }
#pragma unroll
    for (int d0 = 0; d0 < NQ; ++d0) { u32x4 u = *reinterpret_cast<u32x4*>(&qr[d0]);
#pragma unroll
      for (int q = 0; q < 4; ++q) u[q] = cvtpk(blo(u[q]) * C, bhi(u[q]) * C);
      qr[d0] = *reinterpret_cast<bf16x8*>(&u); }
  }
#define RESC(a) do { if (__any((a) < 1.f)) { if (hi == 0) al_l[r32] = (a); asm volatile("s_waitcnt lgkmcnt(0)" ::: "memory"); \
    _Pragma("unroll") for (int r = 0; r < 16; ++r) { const float f_ = al_l[crow(r, hi)]; o[0][r] *= f_; o[1][r] *= f_; o[2][r] *= f_; } } } while (0)
  const int qw = q0 + wv * 32;
#define KP0(j) (TROW(j) - 128)
#define TSKIP(j) (MASK && (j) < nA && (KP0(j) + 63 < qw - 128 || KP0(j) > qw + 159 || KP0(j) + 63 < 0 || KP0(j) >= L))
#define TMASK(j) (MASK && (j) < nA && !(KP0(j) >= qw - 97 && KP0(j) + 63 <= qw + 128 && KP0(j) >= 0 && KP0(j) + 63 < L))
#define PSM(p0, p1, al, j) partialSM<MASK, false>(p0, p1, M, al, TMASK(j), KP0(j), qpos, hi)
  f32x16 pA0, pA1, pB0, pB1; float alA, alB; bf16x8 pa0, pa1, pa2, pa3; const int NT = nA + nB;
  unsigned gq[2][16];
#define ITER(j, PX0, PX1, ALX, SKX, PW0, PW1, SKW, KS, VS, NS) do { WAITT((j) + 1 < NT); if ((j) + 2 < NT) GLDS((j) + 2, NS); \
    SKX = TSKIP(j); \
    if (!SKX) qkt<DK>(PX0, PX1, K_lds + (KS) * KBUF, qr, r32, hi, -M); \
    if (!SKW) { finishSM(PW0, PW1, pa0, pa1, pa2, pa3); pv(o, V_lds + (VS) * VBUF, pa0, pa1, pa2, pa3, r32, hi); } \
    if (!SKX) { PSM(PX0, PX1, ALX, j); RESC(ALX); } } while (0)
  bool skA = false, skB = false;
  WAITT(true); GLDS(2, 2);
  skA = TSKIP(0);
  if (!skA) { qkt<DK>(pA0, pA1, K_lds, qr, r32, hi, 0.f); partialSM<MASK, true>(pA0, pA1, M, alA, TMASK(0), KP0(0), qpos, hi);
    RESC(alA); }
  int jb = 0;
  for (; jb + 4 < NT; jb += 4) {
    ITER(jb + 1, pB0, pB1, alB, skB, pA0, pA1, skA, 1, 0, 3);
    ITER(jb + 2, pA0, pA1, alA, skA, pB0, pB1, skB, 2, 1, 0);
    ITER(jb + 3, pB0, pB1, alB, skB, pA0, pA1, skA, 3, 2, 1);
    ITER(jb + 4, pA0, pA1, alA, skA, pB0, pB1, skB, 0, 3, 2);
  }
  ITER(jb + 1, pB0, pB1, alB, skB, pA0, pA1, skA, 1, 0, 3);
  ITER(jb + 2, pA0, pA1, alA, skA, pB0, pB1, skB, 2, 1, 0);
  WAITT(false);
#pragma unroll
  for (int r = 0; r < 16; ++r) { const size_t go = (size_t)(wid * 32 + crow(r, hi)) * PXW + r32; gq[0][r] = gate[go]; gq[1][r] = gate[go + 32]; }
  __builtin_amdgcn_sched_barrier(0);
  skB = TSKIP(NT - 1);
  if (!skB) qkt<DK>(pB0, pB1, K_lds + 3 * KBUF, qr, r32, hi, -M);
  if (!skA) { finishSM(pA0, pA1, pa0, pa1, pa2, pa3); pv(o, V_lds + 2 * VBUF, pa0, pa1, pa2, pa3, r32, hi); }
  if (!skB) { PSM(pB0, pB1, alB, NT - 1); RESC(alB);
    finishSM(pB0, pB1, pa0, pa1, pa2, pa3); pv(o, V_lds + 3 * VBUF, pa0, pa1, pa2, pa3, r32, hi); }
#pragma unroll
  for (int r = 0; r < 16; ++r) { const int orow = wid * 32 + crow(r, hi); const float rl = __builtin_amdgcn_rcpf(o[2][r]);
#pragma unroll
    for (int d0 = 0; d0 < 2; ++d0) { const int col = d0 * 32 + r32; const float gv = __uint_as_float(gq[d0][r] << 16);
      Yo[(size_t)orow * 1024 + col] = f2bf(o[d0][r] * rl * silu(gv)); } }
  __syncthreads();
#undef KP0
#undef TSKIP
#undef TMASK
#undef TROW
#undef GLDS
#undef WAITT
#undef ITER
#undef RESC
#undef PSM
}

DEVI float2 cmul(float2 a, float2 b) { return make_float2(a.x * b.x - a.y * b.y, a.x * b.y + a.y * b.x); }
DEVI float2 cmulc(float2 a, float2 w) { return make_float2(a.x * w.x + a.y * w.y, a.y * w.x - a.x * w.y); }
DEVI void fft_fwd(float2* x, const float2* __restrict__, int tid) {
  for (int shp = 12; shp >= 0; shp -= 2) { const int sp = 1 << shp; const float inv4s = 0.25f / (float)sp;
#pragma unroll 2
    for (int u = 0; u < 8; ++u) { const int q = tid + 512 * u, pos = q & (sp - 1), i0 = ((q >> shp) << (shp + 2)) | pos;
      const float2 e0 = x[i0], e1 = x[i0 + sp], e2 = x[i0 + 2 * sp], e3 = x[i0 + 3 * sp];
      const float fr = (float)pos * inv4s;
      const float2 wA0 = make_float2(__builtin_amdgcn_cosf(fr), -__builtin_amdgcn_sinf(fr)), wA1 = make_float2(wA0.y, -wA0.x), wB = cmul(wA0, wA0);
      const float2 t0 = make_float2(e0.x + e2.x, e0.y + e2.y), t2 = cmul(make_float2(e0.x - e2.x, e0.y - e2.y), wA0);
      const float2 t1 = make_float2(e1.x + e3.x, e1.y + e3.y), t3 = cmul(make_float2(e1.x - e3.x, e1.y - e3.y), wA1);
      x[i0] = make_float2(t0.x + t1.x, t0.y + t1.y); x[i0 + sp] = cmul(make_float2(t0.x - t1.x, t0.y - t1.y), wB);
      x[i0 + 2 * sp] = make_float2(t2.x + t3.x, t2.y + t3.y); x[i0 + 3 * sp] = cmul(make_float2(t2.x - t3.x, t2.y - t3.y), wB); }
    __syncthreads(); }
}
DEVI void fft_inv(float2* x, const float2* __restrict__, int tid) {
  for (int shp = 0; shp <= 12; shp += 2) { const int sp = 1 << shp; const float inv4s = 0.25f / (float)sp;
#pragma unroll 2
    for (int u = 0; u < 8; ++u) { const int q = tid + 512 * u, pos = q & (sp - 1), i0 = ((q >> shp) << (shp + 2)) | pos;
      const float2 e0 = x[i0], e1 = x[i0 + sp], e2 = x[i0 + 2 * sp], e3 = x[i0 + 3 * sp];
      const float fr = (float)pos * inv4s;
      const float2 wA0 = make_float2(__builtin_amdgcn_cosf(fr), -__builtin_amdgcn_sinf(fr)), wA1 = make_float2(wA0.y, -wA0.x), wB = cmul(wA0, wA0);
      const float2 b1 = cmulc(e1, wB), b3 = cmulc(e3, wB);
      const float2 t0 = make_float2(e0.x + b1.x, e0.y + b1.y), t1 = make_float2(e0.x - b1.x, e0.y - b1.y);
      const float2 t2 = make_float2(e2.x + b3.x, e2.y + b3.y), t3 = make_float2(e2.x - b3.x, e2.y - b3.y);
      const float2 c2 = cmulc(t2, wA0), c3 = cmulc(t3, wA1);
      x[i0] = make_float2(t0.x + c2.x, t0.y + c2.y); x[i0 + 2 * sp] = make_float2(t0.x - c2.x, t0.y - c2.y);
      x[i0 + sp] = make_float2(t1.x + c3.x, t1.y + c3.y); x[i0 + 3 * sp] = make_float2(t1.x - c3.x, t1.y - c3.y); }
    __syncthreads(); }
}
DEVI float block_sum(float v, float* red, int tid) {
  v = wave_sum(v); __syncthreads(); if ((tid & 63) == 0) red[tid >> 6] = v; __syncthreads();
  float t = 0.f;
#pragma unroll
  for (int i = 0; i < 8; ++i) t += red[i];
  __syncthreads(); return t;
}
DEVI float sconv(const bf16_t* __restrict__ u, int t, int len, float w0, float w1, float w2, float b) {
  const float um = t > 0 ? bf2f(u[t - 1]) : 0.f, uc = bf2f(u[t]), up = t + 1 < len ? bf2f(u[t + 1]) : 0.f;
  return um * w0 + uc * w1 + up * w2 + b;
}

DEVI void gbar(unsigned* ctr, unsigned& gen) {
  asm volatile("s_waitcnt vmcnt(0)" ::: "memory");
  __syncthreads();
  gen += 1u;
  if (threadIdx.x < 64) {
    const unsigned lane = threadIdx.x, G = gridDim.x;
    if (lane == 0) {
      __builtin_amdgcn_fence(__ATOMIC_RELEASE, "agent");
      asm volatile("s_waitcnt vmcnt(0)" ::: "memory");
      __hip_atomic_fetch_add(ctr + (blockIdx.x & 7u) * 64u, 1u, __ATOMIC_RELAXED, __HIP_MEMORY_SCOPE_AGENT);
    }
    const unsigned want = lane < 8u ? gen * ((G + 7u - lane) >> 3) : 0u;
    for (;;) { const unsigned v = lane < 8u ? __hip_atomic_load(ctr + lane * 64u, __ATOMIC_RELAXED, __HIP_MEMORY_SCOPE_AGENT) : 0u;
      if (__all(v >= want)) break; __builtin_amdgcn_s_sleep(1); }
    if (lane == 0) {
      __builtin_amdgcn_fence(__ATOMIC_ACQUIRE, "agent");
      asm volatile("s_waitcnt vmcnt(0)" ::: "memory");
    }
  }
  __syncthreads();
}
DEVI void sconv8(const bf16_t* __restrict__ u, int t0, int len, int lane, float w0, float w1, float w2, float b, float (&out)[8]) {
  const u32x4 v = *(const u32x4*)(u + t0);
  float e[10];
  e[1] = blo(v[0]); e[2] = bhi(v[0]); e[3] = blo(v[1]); e[4] = bhi(v[1]); e[5] = blo(v[2]); e[6] = bhi(v[2]); e[7] = blo(v[3]); e[8] = bhi(v[3]);
  float prev = __shfl_up(e[8], 1), next = __shfl_down(e[1], 1);
  if (lane == 0) prev = t0 > 0 ? bf2f(u[t0 - 1]) : 0.f;
  if (lane == 63) next = t0 + 8 < len ? bf2f(u[t0 + 8]) : 0.f;
  e[0] = prev; e[9] = next;
#pragma unroll
  for (int j = 0; j < 8; ++j) out[j] = e[j] * w0 + e[j + 1] * w1 + e[j + 2] * w2 + b;
}
typedef const __attribute__((address_space(4))) P* PKP;
__global__ void __launch_bounds__(512) mega(P p_arg) {
  PKP pk = (PKP)__builtin_amdgcn_kernarg_segment_ptr();
#define p (*pk)
  __shared__ __attribute__((aligned(16))) char lds[149504];
  cg::grid_group grid = cg::this_grid();
  int tid = threadIdx.x; int wid = tid >> 6, lane = tid & 63;
#define RETID() do { tid = threadIdx.x; asm volatile("" : "+v"(tid)); wid = tid >> 6; lane = tid & 63; } while (0)
  const int G = gridDim.x, bid = blockIdx.x;
  char* ws = p.ws;
#define WIN ((bf16_t*)(ws + OFF_WIN))
#define WUQ ((bf16_t*)(ws + OFF_WUQ))
#define WUKV ((bf16_t*)(ws + OFF_WUKV))
#define WOUT ((bf16_t*)(ws + OFF_WOUT))
#define MOD ((float*)(ws + OFF_MOD))
#define TW ((float2*)(ws + OFF_TW))
#define PSUM ((float*)(ws + OFF_PSUM))
#define HKC ((float*)(ws + OFF_HKC))
#define ROPEM ((float2*)(ws + OFF_RPM))
#define ROPES ((float2*)(ws + OFF_RPS))
#define XC ((float*)(ws + OFF_XC))
#define KF ((float2*)(ws + OFF_KF))
#define H ((bf16_t*)(ws + OFF_H))
#define PX ((bf16_t*)(ws + OFF_PX))
#define HT ((bf16_t*)(ws + OFF_HT))
#define HTC ((bf16_t*)(ws + OFF_HTC))
#define QA ((bf16_t*)(ws + OFF_QA))
#define KA ((bf16_t*)(ws + OFF_KA))
#define VTA ((bf16_t*)(ws + OFF_VTA))
#define KS ((bf16_t*)(ws + OFF_KS))
#define VS ((bf16_t*)(ws + OFF_VS))
#define Y ((bf16_t*)(ws + OFF_Y))
#define YHT ((bf16_t*)(ws + OFF_YHT))
#define YHTC ((bf16_t*)(ws + OFF_YHTC))
#define HKT ((float*)(ws + OFF_HKT))
#define REWS() do { asm volatile("" : "+s"(pk)); ws = p.ws; } while (0)
#ifndef PHM
#define PHM 0xffff
#endif
#ifndef REP_P0
#define REP_P0 1
#endif
#ifndef REP_D
#define REP_D 1
#endif
#ifndef REP_B
#define REP_B 1
#endif
#ifndef REP_C
#define REP_C 1
#endif
#ifndef REP_MLA
#define REP_MLA 1
#endif
#ifndef REP_SWA
#define REP_SWA 1
#endif
#ifndef REP_HY
#define REP_HY 1
#endif
#ifndef REP_A
#define REP_A 1
#endif
#ifndef REP_E0
#define REP_E0 1
#endif
#ifndef REP_KF
#define REP_KF 1
#endif
#ifndef REP_D2
#define REP_D2 1
#endif
  REWS();
  unsigned bar_target = 0u;
  if (bid == 0 && tid < 8) __hip_atomic_store((unsigned*)(ws + OFF_BAR) + tid * 64, 0u, __ATOMIC_RELAXED, __HIP_MEMORY_SCOPE_AGENT);
  grid.sync();
#define GSYNC() gbar((unsigned*)(ws + OFF_BAR), bar_target)
  for (int rep = 0; rep < REP_P0; ++rep) {
  if (PHM & 1) {
    constexpr int N_WIN = 2 * 16 * 49, N_WUQ = 2 * 6 * 9, N_WUKV = 2 * 4 * 12, N_WOUT = 2 * 16 * 16, N_MOD = 96, N_HF = 2 * 512, N_HFC = 16, N_MISC = 1 + 64;
    constexpr int E1 = N_WIN, E2 = E1 + N_WUQ, E3 = E2 + N_WUKV, E4 = E3 + N_WOUT, E5 = E4 + N_MOD, E6 = E5 + N_HF, E7 = E6 + N_HFC, E8 = E7 + N_MISC;
    for (int it = bid; it < E8; it += G) {
      __syncthreads(); RETID();
      if (it < E4) {
        const float* src; bf16_t* dst; int K, N, kt, nt, mode, l; const float* kscale = nullptr;
        if (it < E1) { int r = it; l = r / (16 * 49); r -= l * 16 * 49; kt = r / 49; nt = r - kt * 49; K = 1024; N = 3104; src = p.w_in + (size_t)l * K * N; dst = WIN + (size_t)l * NIN * 1024; mode = 0; }
        else if (it < E2) { int r = it - E1; l = r / 54; r -= l * 54; kt = r / 9; nt = r - kt * 9; K = 384; N = 576; src = p.w_uq + (size_t)l * K * N; dst = WUQ + (size_t)l * 576 * 384; mode = 1; kscale = p.q_norm + l * 384; }
        else if (it < E3) { int r = it - E2; l = r / 48; r -= l * 48; kt = r / 12; nt = r - kt * 12; K = 256; N = 768; src = p.w_ukv + (size_t)l * K * N; dst = WUKV + (size_t)l * 768 * 256; mode = 2; kscale = p.kv_norm + l * 256; }
        else { int r = it - E3; l = r / 256; r -= l * 256; kt = r / 16; nt = r - kt * 16; K = 1024; N = 1024; src = p.w_out + (size_t)l * K * N; dst = WOUT + (size_t)l * 1024 * 1024; mode = 1; }
        float* tile = (float*)lds;
        { const int kk = tid >> 4, nq = tid & 15;
#pragma unroll
          for (int i = 0; i < 2; ++i) { const int k = kt * 64 + kk + 32 * i, n = nt * 64 + nq * 4;
            f32x4 v = {0.f, 0.f, 0.f, 0.f}; if (n < N) v = *(const f32x4*)(src + (size_t)k * N + n);
            const float sc = kscale ? kscale[k] : 1.f;
            float* tp = tile + (kk + 32 * i) * 65 + nq * 4; tp[0] = v[0] * sc; tp[1] = v[1] * sc; tp[2] = v[2] * sc; tp[3] = v[3] * sc; } }
        __syncthreads();
        { const int nl = tid >> 3, kc = tid & 7, n = nt * 64 + nl;
          if (n < N) { int np = n; if (mode == 0) np = n < 2080 ? n : n + 96; else if (mode == 2) { const int h = n >> 7, d = n & 127; np = d < 64 ? h * 64 + d : 384 + h * 64 + (d - 64); }
            const float* tp = tile + (kc * 8) * 65 + nl; u32x4 w;
            w[0] = cvtpk(tp[0], tp[65]); w[1] = cvtpk(tp[130], tp[195]); w[2] = cvtpk(tp[260], tp[325]); w[3] = cvtpk(tp[390], tp[455]);
            *(u32x4*)(dst + (size_t)np * K + kt * 64 + kc * 8) = w; } }
      } else if (it < E5) {
        const int r = it - E4, l = r / 48, n0 = (r - l * 48) * 64;
        float* sl = (float*)lds; float* red = sl + 5 * 1024;
        for (int i = tid; i < 5 * 1024; i += 512) { const int v = i >> 10, k = i & 1023; const float cv = v < 4 ? p.c[v * 1024 + k] : p.c_ctx[k]; sl[i] = silu(cv); }
        __syncthreads();
        const int kq = tid >> 6, col = tid & 63; float a0 = 0.f, a1 = 0.f, a2 = 0.f, a3 = 0.f, a4 = 0.f;
        const float* wp = p.mod_w + (size_t)l * 1024 * 3072 + n0 + col;
        for (int k = kq * 128; k < kq * 128 + 128; ++k) { const float w = wp[(size_t)k * 3072];
          a0 += sl[k] * w; a1 += sl[1024 + k] * w; a2 += sl[2048 + k] * w; a3 += sl[3072 + k] * w; a4 += sl[4096 + k] * w; }
        red[(kq * 5 + 0) * 64 + col] = a0; red[(kq * 5 + 1) * 64 + col] = a1; red[(kq * 5 + 2) * 64 + col] = a2; red[(kq * 5 + 3) * 64 + col] = a3; red[(kq * 5 + 4) * 64 + col] = a4;
        __syncthreads();
        if (tid < 320) { const int v = tid >> 6, cc = tid & 63; float s = p.mod_b[l * 3072 + n0 + cc];
#pragma unroll
          for (int q = 0; q < 8; ++q) s += red[(q * 5 + v) * 64 + cc];
          MOD[(l * 5 + v) * 3072 + n0 + cc] = s; }
      } else if (it < E7) {
        int l, Lf, t0; float* dstT; float* ps;
        if (it < E6) { const int r = it - E5; l = r >> 9; Lf = L; t0 = (r & 511) * 16; dstT = HKT + (size_t)l * 512 * L; ps = PSUM + ((size_t)l * 512 + (r & 511)) * 512; }
        else { l = 0; Lf = CT; t0 = (it - E6) * 16; dstT = HKC; ps = nullptr; }
        float* zin = (float*)lds; float* h1 = zin + 16 * 17; float* h2 = h1 + 16 * 64;
        if (tid < 16 * 17) { const int tt = tid / 17, e = tid - tt * 17; const int i = t0 + tt; const float tv = (float)i / (float)(Lf - 1), w = (6.283185307179586f / (float)Lf) * (float)i;
          float v; if (e == 0) v = tv; else { const int k = (e - 1) & 7; const float band = 1e-4f + (float)k * ((7.f - 1e-4f) / 7.f); float s, c; sincosf(band * w, &s, &c); v = e <= 8 ? c : -s; }
          zin[tid] = v; }
        __syncthreads();
        for (int idx = tid; idx < 1024; idx += 512) { const int tt = idx >> 6, j = idx & 63; float a = p.hb1[l * 64 + j];
          for (int e = 0; e < 17; ++e) a += zin[tt * 17 + e] * p.hw1[(l * 17 + e) * 64 + j];
          h1[idx] = sinf(p.hfreq[l * 64 + j] * a); }
        __syncthreads();
        for (int idx = tid; idx < 1024; idx += 512) { const int tt = idx >> 6, j = idx & 63; float a = p.hb2[l * 64 + j];
          for (int k = 0; k < 64; ++k) a += h1[tt * 64 + k] * p.hw2[(l * 64 + k) * 64 + j];
          h2[idx] = sinf(p.hfreq[l * 64 + j] * a); }
        __syncthreads();
        { const int n = tid, c = n & 255; float a[16]; const float b3 = p.hb3[l * 512 + n];
#pragma unroll
          for (int tt = 0; tt < 16; ++tt) a[tt] = b3;
          for (int k = 0; k < 64; ++k) { const float w = p.hw3[(l * 64 + k) * 512 + n];
#pragma unroll
            for (int tt = 0; tt < 16; ++tt) a[tt] += h2[tt * 64 + k] * w; }
          const float fast = -15.350567286626973f, slow = -3.0701134573253945f; const float delta = fabsf(fast + (float)c * ((slow - fast) / 255.f));
          float asum = 0.f;
#pragma unroll
          for (int tt = 0; tt < 16; ++tt) { const int i = t0 + tt; const float tv = (float)i / (float)(Lf - 1); a[tt] *= __expf(-tv * delta); if (!(n >= 256 && i == 0)) asum += fabsf(a[tt]); }
          float* dp = dstT + (size_t)n * Lf + t0;
#pragma unroll
          for (int q = 0; q < 4; ++q) { f32x4 v = {a[4 * q], a[4 * q + 1], a[4 * q + 2], a[4 * q + 3]}; *(f32x4*)(dp + 4 * q) = v; }
          if (ps) ps[n] = asum; }
      } else if (it > E7) {
        const int t0 = (it - E7 - 1) * 128;
        for (int i = tid; i < 128 * 48; i += 512) { const int t = t0 + i / 48, e = i % 48; const float prow = (float)(t >> 6), pcol = (float)(t & 63);
          float ang; if (e < 16) ang = (e < 8 ? prow : pcol) * exp2f(-(float)(e & 7) * 0.125f * 13.287712379549449f);
          else { const int k = e - 16; ang = (k < 16 ? prow : pcol) * exp2f(-(float)(k & 15) * 0.0625f * 13.287712379549449f); }
          float sn, cs; sincosf(ang, &sn, &cs);
          if (e < 16) ROPEM[(size_t)t * 16 + e] = make_float2(cs, sn); else ROPES[(size_t)t * 32 + e - 16] = make_float2(cs, sn); }
      } else {
        for (int k = tid; k < 8192; k += 512) { float s, c; sincospif((float)k * (1.f / 8192.f), &s, &c); TW[k] = make_float2(c, -s); }
        const u32x4 z = {0u, 0u, 0u, 0u};
        for (int i = tid; i < 2 * 96 * 128; i += 512) { const int l = i / (96 * 128), r = i - l * 96 * 128; *(u32x4*)(WIN + ((size_t)l * NIN + 2080) * 1024 + (size_t)r * 8) = z; }
        for (int i = tid; i < 8 * 2 * 128 * 8; i += 512) { const int bg = i >> 11, r = i & 2047, row = (r >> 3) & 127, half = r >> 10, ch = r & 7;
          *(u32x4*)(KS + ((size_t)bg * LKS + (half ? 8320 : 0) + row) * 64 + ch * 8) = z; }
        for (int i = tid; i < 8 * 64 * 2 * 16; i += 512) { const int rowi = i >> 5, r = i & 31, half = r >> 4, ch = r & 15;
          *(u32x4*)(VS + (size_t)rowi * LKS + (half ? 8320 : 0) + ch * 8) = z; }
      }
    }
  }
  GSYNC(); }

  for (int l = 0; l < 2; ++l) {
    const float* xl = l == 0 ? p.x : p.out; const float* xc = l == 0 ? p.ctx : XC;
    const float* modl = MOD + l * 5 * 3072;
    REWS();
    for (int rep = 0; rep < REP_KF; ++rep) if (l == 0 && (PHM & 2)) {
      for (int it = bid; it < 512; it += G) { const int ll = it >> 8, c = it & 255;
        __syncthreads(); RETID();
        float2* x = (float2*)lds; float* red = (float*)(lds + 131072);
        const float part = PSUM[((size_t)ll * 512 + tid) * 512 + c] + PSUM[((size_t)ll * 512 + tid) * 512 + 256 + c];
        const float inv = 1.f / (block_sum(part, red, tid) + EPS);
        const float* hf = HKT + ((size_t)ll * 512 + c) * L; const float* hb = HKT + ((size_t)ll * 512 + 256 + c) * L;
#pragma unroll 8
        for (int u = 0; u < 32; ++u) { const int i = tid + 512 * u; float v;
          if (i < L) v = hf[i] * inv; else if (i == L) v = 0.f; else v = hb[2 * L - i] * inv;
          x[i] = make_float2(v, 0.f); }
        __syncthreads();
        fft_fwd(x, TW, tid);
        float2* kf = KF + ((size_t)ll * 256 + c) * NFFT;
        for (int u = 0; u < 32; ++u) { const int i = tid + 512 * u; const float2 v = x[i]; kf[i] = make_float2(v.x * (1.f / NFFT), v.y * (1.f / NFFT)); }
      }
    }
    RETID();
    for (int rep = 0; rep < REP_A; ++rep) if (PHM & 4) for (int row = bid * 8 + wid; row < TA; row += G * 8) {
      const float* src; int v; if (row < TL) { src = xl + (size_t)row * DM; v = row >> 13; } else { src = xc + (size_t)(row - TL) * DM; v = 4; }
      f32x4 a[4]; float ss = 0.f;
#pragma unroll
      for (int i = 0; i < 4; ++i) { a[i] = *(const f32x4*)(src + 4 * (lane + 64 * i)); ss += a[i][0] * a[i][0] + a[i][1] * a[i][1] + a[i][2] * a[i][2] + a[i][3] * a[i][3]; }
      ss = wave_sum(ss); const float rstd = rsqrtf(ss * (1.f / DM) + EPS);
      const float* mv = modl + v * 3072;
#pragma unroll
      for (int i = 0; i < 4; ++i) { const int col = 4 * (lane + 64 * i);
        const f32x4 g = *(const f32x4*)(p.norm_g + l * DM + col), sh = *(const f32x4*)(mv + col), sc = *(const f32x4*)(mv + 1024 + col);
        *(u32x2*)(H + (size_t)row * DM + col) = pack4(a[i][0] * rstd * g[0] * (1.f + sc[0]) + sh[0], a[i][1] * rstd * g[1] * (1.f + sc[1]) + sh[1],
                                                      a[i][2] * rstd * g[2] * (1.f + sc[2]) + sh[2], a[i][3] * rstd * g[3] * (1.f + sc[3]) + sh[3]); }
    }
    GSYNC();

    REWS();
    for (int rep = 0; rep < REP_B; ++rep) if (PHM & 8) {
      GArgs g{H, DM, WIN + (size_t)l * NIN * 1024, 1024, NIN, nullptr, 0}; EpiIn e{PX, HT, HTC};
      constexpr int NM = TA / 256, NN = NIN / 128, NTILES = NM * NN;
      if (G == 256) {
        const int xcd = bid & 7, slot = bid >> 3, cnt = (NTILES + 7 - xcd) >> 3, base = xcd * (NTILES >> 3) + (xcd < (NTILES & 7) ? xcd : (NTILES & 7));
        for (int seq = slot; seq < cnt; seq += 32) { const int lin = base + seq;
          const int mg = lin / (4 * NN), rem = lin - mg * 4 * NN, n = rem >> 2, m = mg * 4 + (rem & 3);
          if (n < 17) gemm_tile<2, false, true>(lds, g, m * 256, n * 128, e); else gemm_tile<2, false, false>(lds, g, m * 256, n * 128, e); }
      } else for (int it = bid; it < NTILES; it += G) { const int mg = it / (4 * NN), rem = it - mg * 4 * NN, n = rem >> 2, m = mg * 4 + (rem & 3);
          if (n < 17) gemm_tile<2, false, true>(lds, g, m * 256, n * 128, e); else gemm_tile<2, false, false>(lds, g, m * 256, n * 128, e); }
    }
    GSYNC();

    REWS();
    for (int rep = 0; rep < REP_C; ++rep) {
      constexpr int NM = TA / 256;
      constexpr int N1 = NM * 5, N2 = N1 + NM * 3, N3 = N2 + NM * 3, N4 = N3 + 264;
      for (int it0 = bid; it0 < N4; it0 += G) {
        if (it0 < N1) { const int m = it0 / 5, n = it0 - m * 5;
          GArgs g{PX + C_MQ, PXW, WUQ + (size_t)l * 576 * 384, 384, 576, nullptr, 0}; EpiQ e{QA};
          gemm_tile<0, true, true>(lds, g, m * 256, n * 128, e); continue; }
        if (it0 < N2) { const int r = it0 - N1, m = r / 3, n = r - m * 3;
          GArgs g{PX + C_MKV, PXW, WUKV + (size_t)l * 768 * 256, 256, 768, nullptr, 0}; EpiKV e{KA, VTA};
          gemm_tile<0, true, true>(lds, g, m * 256, n * 128, e); continue; }
        if (it0 < N3) { const int r = it0 - N2, m = r / 3, n = 3 + r - m * 3;
          GArgs g{PX + C_MKV, PXW, WUKV + (size_t)l * 768 * 256, 256, 768, nullptr, 0}; EpiKV e{KA, VTA};
          gemm_tile<0, true, false>(lds, g, m * 256, n * 128, e); continue; }
        const int it = it0 - N3; {
        const int r0 = it * 128; RETID();
#pragma unroll
        for (int rr = tid >> 4; rr < 128; rr += 32) { const int m = r0 + rr, i = tid & 15; int b, krow; row_to_bk(m, b, krow);
          float x1 = bf2f(PX[(size_t)m * PXW + C_MKR + i]), x2 = bf2f(PX[(size_t)m * PXW + C_MKR + 16 + i]);
          if (m < TL) { const float2 cs = ROPEM[(size_t)krow * 16 + i]; const float y1 = x1 * cs.x - x2 * cs.y, y2 = x2 * cs.x + x1 * cs.y; x1 = y1; x2 = y2; }
          const bf16_t o1 = f2bf(x1), o2 = f2bf(x2);
#pragma unroll
          for (int h = 0; h < 6; ++h) { bf16_t* d = KA + ((size_t)(b * 6 + h) * LK + krow) * 96 + 64; d[i] = o1; d[16 + i] = o2; } }
#pragma unroll 8
        for (int rr = tid >> 6; rr < 128; rr += 8) { const int m = r0 + rr, gi = (tid >> 5) & 1, i = tid & 31; int b, krow; row_to_bk(m, b, krow);
          float x1 = bf2f(PX[(size_t)m * PXW + C_SK + gi * 64 + i]), x2 = bf2f(PX[(size_t)m * PXW + C_SK + gi * 64 + 32 + i]);
          int srow;
          if (m < TL) { const float2 cs = ROPES[(size_t)krow * 32 + i]; const float y1 = x1 * cs.x - x2 * cs.y, y2 = x2 * cs.x + x1 * cs.y; x1 = y1; x2 = y2; srow = 128 + krow; }
          else srow = 8448 + (krow - L);
          bf16_t* d = KS + ((size_t)(b * 2 + gi) * LKS + srow) * 64; d[i] = f2bf(x1); d[32 + i] = f2bf(x2); }
#pragma unroll
        for (int cc = tid >> 7; cc < 16; cc += 4) { const int gd = tid & 127, m = r0 + cc * 8; int b, krow; row_to_bk(m, b, krow);
          const int srow = m < TL ? 128 + krow : 8448 + (krow - L);
          const bf16_t* sp = PX + (size_t)m * PXW + C_SV + gd;
          const unsigned v0 = sp[0], v1 = sp[PXW], v2 = sp[2 * PXW], v3 = sp[3 * PXW], v4 = sp[4 * PXW], v5 = sp[5 * PXW], v6 = sp[6 * PXW], v7 = sp[7 * PXW];
          u32x4 w; w[0] = v0 | (v1 << 16); w[1] = v2 | (v3 << 16); w[2] = v4 | (v5 << 16); w[3] = v6 | (v7 << 16);
          *(u32x4*)(VS + ((size_t)(b * 2 + (gd >> 6)) * 64 + (gd & 63)) * LKS + srow) = w; }
        } }
    }
    GSYNC();

    REWS();
    for (int rep = 0; rep < REP_D; ++rep) {
      const float sc_mla = 0.10206207261596577f, sc_swa = 0.125f;
      for (int rep2 = 0; rep2 < REP_MLA; ++rep2) if (PHM & 256) for (int it = bid; it < (l == 0 ? 792 : 768); it += G) {
        int bh, qb; const bool isctx = it >= 768;
        if (!isctx) { const int round = it >> 8, within = it & 255; bh = round * 8 + (within & 7); qb = within >> 3; } else { bh = it - 768; qb = 0; }
        const int b = bh / 6, h = bh - b * 6, q0 = qb * 256, tok0 = isctx ? TL + b * CT : b * L + q0;
        attn_body<96, false>(lds, QA + ((size_t)bh * LK + (isctx ? L : q0)) * 96, 96, KA + (size_t)bh * LK * 96, VTA + (size_t)bh * 64 * LK, LK,
                             isctx ? L : 0, isctx ? 4 : 132, 0, 0, sc_mla, -1e30f, 0.f, q0, isctx ? nullptr : ROPEM,
                             PX + (size_t)tok0 * PXW + C_MG + h * 64, Y + (size_t)tok0 * 1024 + h * 64);
      }
      for (int rep2 = 0; rep2 < REP_SWA; ++rep2) if (PHM & 512) for (int it = bid; it < (l == 0 ? 792 : 768); it += G) {
        int bh, qb; const bool isctx = it >= 768;
        if (!isctx) { const int round = it >> 8, within = it & 255; bh = round * 8 + (within & 7); qb = within >> 3; } else { bh = it - 768; qb = 0; }
        const int b = bh / 6, h = bh - b * 6, gi = h / 3, q0 = qb * 256, tok0 = isctx ? TL + b * CT : b * L + q0;
        attn_body<64, true>(lds, PX + (size_t)tok0 * PXW + C_SQ + h * 64, PXW, KS + (size_t)(b * 2 + gi) * LKS * 64, VS + (size_t)(b * 2 + gi) * 64 * LKS, LKS,
                            q0, isctx ? 0 : 8, 8448, 4, sc_swa, p.sink[l * 6 + h], 1.f, q0, isctx ? nullptr : ROPES,
                            PX + (size_t)tok0 * PXW + C_SG + h * 64, Y + (size_t)tok0 * 1024 + 384 + h * 64);
      }
      for (int rep2 = 0; rep2 < REP_HY; ++rep2) if (PHM & 1024) for (int it = bid; it < 512; it += G) {
        __syncthreads(); RETID();
        const int c = it >> 1, bp = it & 1;
        float2* x = (float2*)lds;
        const float* cw = p.conv_w + l * 3 * 768; const float* cb = p.conv_b + l * 768;
        const float w10 = cw[256 + c], w11 = cw[768 + 256 + c], w12 = cw[1536 + 256 + c], b1 = cb[256 + c];
        const float w20 = cw[512 + c], w21 = cw[768 + 512 + c], w22 = cw[1536 + 512 + c], b2 = cb[512 + c];
        const float w00 = cw[c], w01 = cw[768 + c], w02 = cw[1536 + c], b0 = cb[c];
        const bf16_t* u0 = HT + ((size_t)((2 * bp) * 1024)) * L; const bf16_t* u1 = HT + ((size_t)((2 * bp + 1) * 1024)) * L;
#pragma unroll
        for (int u = 0; u < 2; ++u) { const int t0 = (tid + 512 * u) * 8;
          float a1[8], a2[8], c1[8], c2[8];
          sconv8(u0 + (size_t)(512 + c) * L, t0, L, lane, w20, w21, w22, b2, a2); sconv8(u0 + (size_t)(256 + c) * L, t0, L, lane, w10, w11, w12, b1, a1);
          sconv8(u1 + (size_t)(512 + c) * L, t0, L, lane, w20, w21, w22, b2, c2); sconv8(u1 + (size_t)(256 + c) * L, t0, L, lane, w10, w11, w12, b1, c1);
#pragma unroll
          for (int j = 0; j < 4; ++j) { f32x4 v = {a1[2 * j] * a2[2 * j], c1[2 * j] * c2[2 * j], a1[2 * j + 1] * a2[2 * j + 1], c1[2 * j + 1] * c2[2 * j + 1]};
            *(f32x4*)(x + t0 + 2 * j) = v; const f32x4 z = {0.f, 0.f, 0.f, 0.f}; *(f32x4*)(x + L + t0 + 2 * j) = z; } }
        __syncthreads();
        fft_fwd(x, TW, tid);
        { const f32x4* kf = (const f32x4*)(KF + ((size_t)l * 256 + c) * NFFT);
#pragma unroll 4
          for (int u = 0; u < 16; ++u) { const int i = tid + 512 * u; const f32x4 a = *(const f32x4*)(x + 2 * i), k = kf[i];
            f32x4 r = {a[0] * k[0] - a[1] * k[1], a[0] * k[1] + a[1] * k[0], a[2] * k[2] - a[3] * k[3], a[2] * k[3] + a[3] * k[2]}; *(f32x4*)(x + 2 * i) = r; } }
        __syncthreads();
        fft_inv(x, TW, tid);
        const float bias = p.hbias[l * 256 + c];
#pragma unroll
        for (int u = 0; u < 2; ++u) { const int t0 = (tid + 512 * u) * 8;
          f32x4 yv[4];
#pragma unroll
          for (int j = 0; j < 4; ++j) yv[j] = *(const f32x4*)(x + t0 + 2 * j);
#pragma unroll
          for (int q = 0; q < 2; ++q) { const bf16_t* uu = q ? u1 : u0; const int b = 2 * bp + q;
            float a1[8], a2[8], a0[8];
            sconv8(uu + (size_t)(512 + c) * L, t0, L, lane, w20, w21, w22, b2, a2); sconv8(uu + (size_t)(256 + c) * L, t0, L, lane, w10, w11, w12, b1, a1);
            sconv8(uu + (size_t)c * L, t0, L, lane, w00, w01, w02, b0, a0);
            const u32x4 hgv = *(const u32x4*)(uu + (size_t)(768 + c) * L + t0);
            float r[8];
#pragma unroll
            for (int j = 0; j < 8; ++j) { const float yy = yv[j >> 1][(j & 1) * 2 + q]; const float hg = (j & 1) ? bhi(hgv[j >> 1]) : blo(hgv[j >> 1]);
              r[j] = a0[j] * (yy + bias * (a1[j] * a2[j])) * silu(hg); }
            u32x4 w; w[0] = cvtpk(r[0], r[1]); w[1] = cvtpk(r[2], r[3]); w[2] = cvtpk(r[4], r[5]); w[3] = cvtpk(r[6], r[7]);
            *(u32x4*)(YHT + ((size_t)(b * 256 + c)) * L + t0) = w; } }
      }
      if ((PHM & 2048) && l == 0) for (int it = bid; it < 256; it += G) {
        __syncthreads(); RETID();
        const int c = it;
        float* hf = (float*)lds; float* hb = hf + 256; float* zz = hb + 256; float* red = zz + 1024;
        float part = 0.f;
        if (tid < 256) { const float v = HKC[(size_t)c * CT + tid]; hf[tid] = v; part = fabsf(v); } else { const int t = tid - 256; const float v = HKC[(size_t)(256 + c) * CT + t]; hb[t] = v; part = t > 0 ? fabsf(v) : 0.f; }
        const float inv = 1.f / (block_sum(part, red, tid) + EPS);
        const float* cw = p.conv_w; const float* cb = p.conv_b;
        const float w10 = cw[256 + c], w11 = cw[768 + 256 + c], w12 = cw[1536 + 256 + c], b1 = cb[256 + c];
        const float w20 = cw[512 + c], w21 = cw[768 + 512 + c], w22 = cw[1536 + 512 + c], b2 = cb[512 + c];
        const float w00 = cw[c], w01 = cw[768 + c], w02 = cw[1536 + c], b0 = cb[c];
        for (int i = tid; i < 1024; i += 512) { const int b = i >> 8, t = i & 255; const bf16_t* uu = HTC + (size_t)(b * 1024) * CT;
          zz[i] = sconv(uu + (size_t)(512 + c) * CT, t, CT, w20, w21, w22, b2) * sconv(uu + (size_t)(256 + c) * CT, t, CT, w10, w11, w12, b1); }
        __syncthreads();
        const float bias = p.hbias[c];
        for (int i = tid; i < 1024; i += 512) { const int b = i >> 8, t = i & 255; const float* zb = zz + b * 256; float acc = 0.f;
          for (int s = 0; s <= t; ++s) acc += zb[s] * hf[t - s];
          for (int s = t + 1; s < 256; ++s) acc += zb[s] * hb[s - t];
          const bf16_t* uu = HTC + (size_t)(b * 1024) * CT;
          const float x0 = sconv(uu + (size_t)c * CT, t, CT, w00, w01, w02, b0), hg = bf2f(uu[(size_t)(768 + c) * CT + t]);
          Y[(size_t)(TL + b * CT + t) * 1024 + 768 + c] = f2bf(x0 * (acc * inv + bias * zb[t]) * silu(hg)); }
      }
    }
    GSYNC();

    REWS();
    for (int rep = 0; rep < REP_D2; ++rep) {
      const bool ctx_here = (l == 0) && (G == 256);
      if (ctx_here && bid < 32) {
        EpiOut e{xl, xc, p.out, XC, modl};
        GArgs g{Y, 1024, WOUT + (size_t)l * 1024 * 1024, 1024, 1024, nullptr, 0};
        gemm_tile<2, false, true>(lds, g, (TL / 256 + (bid >> 3)) * 256, (bid & 7) * 128, e);
      } else
      for (int it = (ctx_here ? bid - 32 : bid); it < 2048; it += (ctx_here ? G - 32 : G)) {
        __syncthreads(); RETID();
        const bf16_t* src; int ld, tokbase, cb;
        { const int b = it >> 9, cblk = (it >> 7) & 3, tblk = it & 127; src = YHT + ((size_t)(b * 256 + cblk * 64)) * L + tblk * 64; ld = L; tokbase = b * L + tblk * 64; cb = cblk * 64; }
        unsigned* tile = (unsigned*)lds;
        { const int c = tid >> 3, ch = tid & 7; const u32x4 v = *(const u32x4*)(src + (size_t)c * ld + ch * 8);
          unsigned* tp = tile + c * 33 + ch * 4; tp[0] = v[0]; tp[1] = v[1]; tp[2] = v[2]; tp[3] = v[3]; }
        __syncthreads();
        { const int t = tid >> 3, cch = tid & 7; const bf16_t* tb = (const bf16_t*)tile; unsigned e[8];
#pragma unroll
          for (int j = 0; j < 8; ++j) e[j] = tb[(cch * 8 + j) * 66 + t];
          u32x4 w; w[0] = e[0] | (e[1] << 16); w[1] = e[2] | (e[3] << 16); w[2] = e[4] | (e[5] << 16); w[3] = e[6] | (e[7] << 16);
          *(u32x4*)(Y + (size_t)(tokbase + t) * 1024 + 768 + cb + cch * 8) = w; }
      }
    }
    GSYNC();
    REWS();
    for (int rep = 0; rep < (l == 0 ? REP_E0 : 1); ++rep) if (PHM & 64) {
      const int NM = (l == 0 && G != 256) ? TA / 256 : TL / 256; const int NTILES = NM * 8;
      EpiOut e{xl, xc, p.out, XC, modl};
      GArgs g{Y, 1024, WOUT + (size_t)l * 1024 * 1024, 1024, 1024, nullptr, 0};
      if (G == 256) { const int xcd = bid & 7, slot = bid >> 3;
        for (int mg = xcd; mg * 4 < NM; mg += 8) { const int m = mg * 4 + (slot & 3), n = slot >> 2;
          if (m < NM) gemm_tile<2, false, true>(lds, g, m * 256, n * 128, e); }
      } else for (int it = bid; it < NTILES; it += G) { const int m = it >> 3, n = it & 7;
        gemm_tile<2, false, true>(lds, g, m * 256, n * 128, e);
      }
    }
    GSYNC();
  }
  RETID();
  for (int row0 = bid * 8 + wid; row0 < TL; row0 += G * 16) {
    f32x4 a[2][4]; float ss[2] = {0.f, 0.f};
#pragma unroll
    for (int rr = 0; rr < 2; ++rr) { const int row = row0 + rr * G * 8; if (row < TL) { const float* src = p.out + (size_t)row * DM;
#pragma unroll
        for (int i = 0; i < 4; ++i) { a[rr][i] = *(const f32x4*)(src + 4 * (lane + 64 * i)); ss[rr] += a[rr][i][0] * a[rr][i][0] + a[rr][i][1] * a[rr][i][1] + a[rr][i][2] * a[rr][i][2] + a[rr][i][3] * a[rr][i][3]; } } }
#pragma unroll
    for (int rr = 0; rr < 2; ++rr) { const int row = row0 + rr * G * 8; if (row < TL) { float* src = p.out + (size_t)row * DM;
        const float rstd = rsqrtf(wave_sum(ss[rr]) * (1.f / DM) + EPS);
#pragma unroll
        for (int i = 0; i < 4; ++i) { const int col = 4 * (lane + 64 * i); const f32x4 g = *(const f32x4*)(p.fnorm + col);
          f32x4 o = {a[rr][i][0] * rstd * g[0], a[rr][i][1] * rstd * g[1], a[rr][i][2] * rstd * g[2], a[rr][i][3] * rstd * g[3]}; *(f32x4*)(src + col) = o; } } }
  }
}

#undef p
extern "C" void kernel_launch(void* const* d_in, const int* in_sizes, int n_in, void* d_out, int out_size, void* d_ws, size_t ws_size, hipStream_t stream) {
  static int grid_blocks = 0;
  if (!grid_blocks) {
    int dev = 0, cus = 0, per_cu = 0;
    hipGetDevice(&dev);
    hipDeviceGetAttribute(&cus, hipDeviceAttributeMultiprocessorCount, dev);
    hipOccupancyMaxActiveBlocksPerMultiprocessor(&per_cu, mega, 512, 0);
    if (per_cu < 1) per_cu = 1;
    grid_blocks = cus * 1;
    if (ws_size < WS_END) fprintf(stderr, "kernel_launch: workspace too small: %zu < %zu\n", ws_size, (size_t)WS_END);
  }
  P p{};
  const float** pp = (const float**)&p;
  for (int i = 0; i < 25; ++i) pp[i] = (const float*)d_in[i];
  p.out = (float*)d_out; p.ws = (char*)d_ws;
  void* args[] = {&p};
  hipError_t e = hipLaunchCooperativeKernel((void*)mega, dim3(grid_blocks), dim3(512), args, 0, stream);
  if (e != hipSuccess) fprintf(stderr, "cooperative launch failed: %s (grid %d)\n", hipGetErrorString(e), grid_blocks);
}
```

```cpp
#include <hip/hip_runtime.h>
#include <hip/hip_cooperative_groups.h>
#include <cstdint>
#include <cstdio>
namespace cg = cooperative_groups;

typedef unsigned short bf16_t;
using bf16x8 = __attribute__((ext_vector_type(8))) short;
using f32x16 = __attribute__((ext_vector_type(16))) float;
using f32x4  = __attribute__((ext_vector_type(4))) float;
using u32x4  = __attribute__((ext_vector_type(4))) unsigned;
using u32x2  = __attribute__((ext_vector_type(2))) unsigned;
#define DEVI __device__ __forceinline__

constexpr int NB = 4, L = 8192, CT = 256, DM = 1024;
constexpr int TL = NB * L, TC = NB * CT, TA = TL + TC;
constexpr int PXW = 2080;
constexpr int NIN = 3200;
constexpr int LK = 8448, LKS = 8704;
constexpr int C_MQ = 0, C_MKV = 384, C_MKR = 640, C_MG = 672, C_SQ = 1056, C_SK = 1440, C_SV = 1568, C_SG = 1696;
constexpr float EPS = 1e-6f;
constexpr int NFFT = 16384;

constexpr size_t al256(size_t x) { return (x + 255) / 256 * 256; }
constexpr size_t OFF_WIN  = 0;
constexpr size_t OFF_WUQ  = OFF_WIN  + al256((size_t)2 * NIN * 1024 * 2);
constexpr size_t OFF_WUKV = OFF_WUQ  + al256((size_t)2 * 576 * 384 * 2);
constexpr size_t OFF_WOUT = OFF_WUKV + al256((size_t)2 * 768 * 256 * 2);
constexpr size_t OFF_MOD  = OFF_WOUT + al256((size_t)2 * 1024 * 1024 * 2);
constexpr size_t OFF_TW   = OFF_MOD  + al256((size_t)2 * 5 * 3072 * 4);
constexpr size_t OFF_PSUM = OFF_TW   + al256((size_t)8192 * 8);
constexpr size_t OFF_HKC  = OFF_PSUM + al256((size_t)2 * 512 * 512 * 4);
constexpr size_t OFF_XC   = OFF_HKC  + al256((size_t)512 * 256 * 4);
constexpr size_t OFF_RPM  = OFF_XC   + al256((size_t)TC * 1024 * 4);
constexpr size_t OFF_RPS  = OFF_RPM  + al256((size_t)L * 16 * 8);
constexpr size_t OFF_KF   = OFF_RPS  + al256((size_t)L * 32 * 8);
constexpr size_t OFF_H    = OFF_KF   + al256((size_t)2 * 256 * NFFT * 8);
constexpr size_t OFF_PX   = OFF_H    + al256((size_t)TA * 1024 * 2);
constexpr size_t OFF_HT   = OFF_PX   + al256((size_t)TA * PXW * 2);
constexpr size_t OFF_HTC  = OFF_HT   + al256((size_t)NB * 1024 * L * 2);
constexpr size_t OFF_QA   = OFF_HTC  + al256((size_t)NB * 1024 * CT * 2);
constexpr size_t OFF_KA   = OFF_QA   + al256((size_t)NB * 6 * LK * 96 * 2);
constexpr size_t OFF_VTA  = OFF_KA   + al256((size_t)NB * 6 * LK * 96 * 2);
constexpr size_t OFF_KS   = OFF_VTA  + al256((size_t)NB * 6 * 64 * LK * 2);
constexpr size_t OFF_VS   = OFF_KS   + al256((size_t)NB * 2 * LKS * 64 * 2);
constexpr size_t OFF_BAR  = OFF_VS   + al256((size_t)NB * 2 * LKS * 64 * 2);
constexpr size_t OFF_YHT  = OFF_BAR  + 4096;
constexpr size_t OFF_YHTC = OFF_YHT  + al256((size_t)NB * 256 * L * 2);
constexpr size_t WS_END   = OFF_YHTC + al256((size_t)NB * 256 * CT * 2);
constexpr size_t OFF_Y = OFF_H;
constexpr size_t OFF_HKT = OFF_PX;

struct P {
  const float *x, *c, *ctx, *c_ctx, *norm_g, *mod_w, *mod_b, *w_in, *q_norm, *w_uq, *kv_norm, *w_ukv, *sink, *conv_w, *conv_b,
              *hw1, *hb1, *hfreq, *hw2, *hb2, *hw3, *hb3, *hbias, *w_out, *fnorm;
  float* out; char* ws;
};

typedef __bf16 bf16n2 __attribute__((ext_vector_type(2)));
typedef float f32x2 __attribute__((ext_vector_type(2)));
DEVI unsigned cvtpk(float lo, float hi) { f32x2 v = {lo, hi}; bf16n2 r = __builtin_convertvector(v, bf16n2); return __builtin_bit_cast(unsigned, r); }
DEVI float bf2f(bf16_t v) { return __uint_as_float((unsigned)v << 16); }
DEVI bf16_t f2bf(float f) { return (bf16_t)(cvtpk(f, f) & 0xffffu); }
DEVI float blo(unsigned w) { return __uint_as_float(w << 16); }
DEVI float bhi(unsigned w) { return __uint_as_float(w & 0xffff0000u); }
DEVI int crow(int r, int hi) { return (r & 3) + 8 * (r >> 2) + 4 * hi; }
DEVI float silu(float g) { return g / (1.f + __expf(-g)); }
DEVI int swz128(int row, int chunk) { return row * 128 + ((chunk ^ ((row >> 1) & 7)) << 4); }
DEVI float wave_sum(float v) { for (int o = 32; o > 0; o >>= 1) v += __shfl_xor(v, o); return v; }

struct GArgs { const bf16_t* A; int lda; const bf16_t* Bt; int K; int nB; const bf16_t* At; int ldt; };
template <int AMODE, bool NORM, bool SWAP, class Epi>
DEVI void gemm_tile(char* lds, const GArgs& g, int m0, int n0, const Epi& epi) {
  int tid_ = threadIdx.x; asm volatile("" : "+v"(tid_));
  const int tid = tid_, wid = tid >> 6, lane = tid & 63, r32 = lane & 31, hi = lane >> 5;
  const int wm = wid & 3, wn = wid >> 2;
  char* sA = lds; char* sB = lds + 65536; float* rs = (float*)(lds + 98304);
  f32x16 acc[2][2];
#pragma unroll
  for (int i = 0; i < 2; ++i)
#pragma unroll
    for (int j = 0; j < 2; ++j)
#pragma unroll
      for (int r = 0; r < 16; ++r) acc[i][j][r] = 0.f;
  const int KT = g.K >> 6;
  const int srow = tid >> 3, sch = tid & 7;
  u32x4 Xa0, Xa1, Xa2, Xa3, Xb0, Xb1, Ya0, Ya1, Ya2, Ya3, Yb0, Yb1;
  float ss0 = 0.f, ss1 = 0.f, ss2 = 0.f, ss3 = 0.f;
  const u32x4 zero4 = {0u, 0u, 0u, 0u};
#define G_LOAD(S, kt) do { { const bf16_t* s_ = g.A + (size_t)(m0 + srow) * g.lda + (kt) * 64 + sch * 8; \
      S##a0 = *(const u32x4*)(s_); S##a1 = *(const u32x4*)(s_ + (size_t)64 * g.lda); S##a2 = *(const u32x4*)(s_ + (size_t)128 * g.lda); S##a3 = *(const u32x4*)(s_ + (size_t)192 * g.lda); } \
    { const int n_ = n0 + srow; const bf16_t* s_ = g.Bt + (size_t)n_ * g.K + (kt) * 64 + sch * 8; \
      S##b0 = (n_ < g.nB) ? *(const u32x4*)(s_) : zero4; S##b1 = (n_ + 64 < g.nB) ? *(const u32x4*)(s_ + (size_t)64 * g.K) : zero4; } } while (0)
#define SSQ(acc_, v_) do { _Pragma("unroll") for (int q_ = 0; q_ < 4; ++q_) { float a_ = blo(v_[q_]), b_ = bhi(v_[q_]); acc_ += a_ * a_ + b_ * b_; } } while (0)
#define G_WRITE(S, buf) do { char* a_ = sA + (buf) * 32768; char* b_ = sB + (buf) * 16384; \
    *(u32x4*)(a_ + swz128(srow, sch)) = S##a0; *(u32x4*)(a_ + swz128(srow + 64, sch)) = S##a1; *(u32x4*)(a_ + swz128(srow + 128, sch)) = S##a2; *(u32x4*)(a_ + swz128(srow + 192, sch)) = S##a3; \
    if (NORM) { SSQ(ss0, S##a0); SSQ(ss1, S##a1); SSQ(ss2, S##a2); SSQ(ss3, S##a3); } \
    *(u32x4*)(b_ + swz128(srow, sch)) = S##b0; *(u32x4*)(b_ + swz128(srow + 64, sch)) = S##b1; } while (0)
#define G_COMPUTE(buf) do { const char* a_ = sA + (buf) * 32768; const char* b_ = sB + (buf) * 16384; \
    _Pragma("unroll") for (int kk = 0; kk < 4; ++kk) { bf16x8 af[2], bfr[2]; \
      _Pragma("unroll") for (int mi = 0; mi < 2; ++mi) af[mi] = *(const bf16x8*)(a_ + swz128(wm * 64 + mi * 32 + r32, kk * 2 + hi)); \
      _Pragma("unroll") for (int ni = 0; ni < 2; ++ni) bfr[ni] = *(const bf16x8*)(b_ + swz128(wn * 64 + ni * 32 + r32, kk * 2 + hi)); \
      _Pragma("unroll") for (int mi = 0; mi < 2; ++mi) _Pragma("unroll") for (int ni = 0; ni < 2; ++ni) \
          acc[mi][ni] = SWAP ? __builtin_amdgcn_mfma_f32_32x32x16_bf16(bfr[ni], af[mi], acc[mi][ni], 0, 0, 0) \
                             : __builtin_amdgcn_mfma_f32_32x32x16_bf16(af[mi], bfr[ni], acc[mi][ni], 0, 0, 0); } } while (0)
  f32x4 xp[8];
  if constexpr (AMODE == 2) {
    static_assert(!NORM, "the DMA path does not see the operands in registers");
    asm volatile("s_waitcnt vmcnt(0)" ::: "memory");
    const int gch = sch ^ ((srow >> 1) & 7);
    const bf16_t* gA = g.A + (size_t)(m0 + srow) * g.lda + gch * 8;
    int nb0 = n0 + srow, nb1 = n0 + srow + 64; nb0 = nb0 < g.nB ? nb0 : g.nB - 1; nb1 = nb1 < g.nB ? nb1 : g.nB - 1;
    const bf16_t* gB0 = g.Bt + (size_t)nb0 * g.K + gch * 8; const bf16_t* gB1 = g.Bt + (size_t)nb1 * g.K + gch * 8;
    const int wv = __builtin_amdgcn_readfirstlane(wid);
    char* dA = lds + wv * 1024; char* dB = lds + 98304 + wv * 1024;
#define GLDS(kt, b) do { const int ko_ = (kt) * 64; char* a_ = dA + (b) * 32768; char* b_ = dB + (b) * 16384; \
      __builtin_amdgcn_global_load_lds((const unsigned*)(gA + ko_), (unsigned*)(a_), 16, 0, 0); \
      __builtin_amdgcn_global_load_lds((const unsigned*)(gA + (size_t)64 * g.lda + ko_), (unsigned*)(a_ + 8192), 16, 0, 0); \
      __builtin_amdgcn_global_load_lds((const unsigned*)(gA + (size_t)128 * g.lda + ko_), (unsigned*)(a_ + 16384), 16, 0, 0); \
      __builtin_amdgcn_global_load_lds((const unsigned*)(gA + (size_t)192 * g.lda + ko_), (unsigned*)(a_ + 24576), 16, 0, 0); \
      __builtin_amdgcn_global_load_lds((const unsigned*)(gB0 + ko_), (unsigned*)(b_), 16, 0, 0); \
      __builtin_amdgcn_global_load_lds((const unsigned*)(gB1 + ko_), (unsigned*)(b_ + 8192), 16, 0, 0); } while (0)
    GLDS(0, 0); GLDS(1, 1);
    int buf = 0, wbuf = 2; const int KP = KT - 8;
    for (int kt = 0; kt < KT; ++kt) {
      if (kt + 1 >= KT) asm volatile("s_waitcnt vmcnt(0)" ::: "memory");
      else if (Epi::PRE && (kt == KP + 1 || kt == KP + 2)) asm volatile("s_waitcnt vmcnt(14)" ::: "memory");
      else asm volatile("s_waitcnt vmcnt(6)" ::: "memory");
      asm volatile("s_waitcnt lgkmcnt(0)" ::: "memory"); __builtin_amdgcn_s_barrier();
      if (kt + 2 < KT) GLDS(kt + 2, wbuf);
      if constexpr (Epi::PRE) { if (kt == KP) epi.pre(xp, m0, n0, wm, wn, r32, hi); }
      { const char* a_ = lds + buf * 32768; const char* b_ = lds + 98304 + buf * 16384;
#pragma unroll
        for (int kk = 0; kk < 4; ++kk) { bf16x8 af[2], bfr[2];
#pragma unroll
          for (int mi = 0; mi < 2; ++mi) af[mi] = *(const bf16x8*)(a_ + swz128(wm * 64 + mi * 32 + r32, kk * 2 + hi));
#pragma unroll
          for (int ni = 0; ni < 2; ++ni) bfr[ni] = *(const bf16x8*)(b_ + swz128(wn * 64 + ni * 32 + r32, kk * 2 + hi));
#pragma unroll
          for (int mi = 0; mi < 2; ++mi)
#pragma unroll
            for (int ni = 0; ni < 2; ++ni)
              acc[mi][ni] = SWAP ? __builtin_amdgcn_mfma_f32_32x32x16_bf16(bfr[ni], af[mi], acc[mi][ni], 0, 0, 0)
                                 : __builtin_amdgcn_mfma_f32_32x32x16_bf16(af[mi], bfr[ni], acc[mi][ni], 0, 0, 0); } }
      buf = buf == 2 ? 0 : buf + 1; wbuf = wbuf == 2 ? 0 : wbuf + 1;
    }
#undef GLDS
    epi.template run<SWAP>(acc, m0, n0, wm, wn, r32, hi, rs, xp);
    __syncthreads();
    return;
  }
  G_LOAD(X, 0); G_LOAD(Y, 1); G_WRITE(X, 0); __syncthreads();
  for (int kt = 0; kt < KT; kt += 2) {
    if constexpr (Epi::PRE) { if (kt == KT - 8) epi.pre(xp, m0, n0, wm, wn, r32, hi); }
    if (kt + 2 < KT) G_LOAD(X, kt + 2);
    G_COMPUTE(0);
    G_WRITE(Y, 1);
    __syncthreads();
    if (kt + 3 < KT) G_LOAD(Y, kt + 3);
    G_COMPUTE(1);
    if (kt + 2 < KT) { G_WRITE(X, 0); }
    __syncthreads();
  }
  if (NORM) {
    ss0 += __shfl_xor(ss0, 1); ss0 += __shfl_xor(ss0, 2); ss0 += __shfl_xor(ss0, 4);
    ss1 += __shfl_xor(ss1, 1); ss1 += __shfl_xor(ss1, 2); ss1 += __shfl_xor(ss1, 4);
    ss2 += __shfl_xor(ss2, 1); ss2 += __shfl_xor(ss2, 2); ss2 += __shfl_xor(ss2, 4);
    ss3 += __shfl_xor(ss3, 1); ss3 += __shfl_xor(ss3, 2); ss3 += __shfl_xor(ss3, 4);
    if (sch == 0) { const float ik = 1.f / (float)g.K;
      rs[srow] = rsqrtf(ss0 * ik + EPS); rs[srow + 64] = rsqrtf(ss1 * ik + EPS); rs[srow + 128] = rsqrtf(ss2 * ik + EPS); rs[srow + 192] = rsqrtf(ss3 * ik + EPS); }
    __syncthreads();
  }
  epi.template run<SWAP>(acc, m0, n0, wm, wn, r32, hi, rs, xp);
  __syncthreads();
#undef G_LOAD
#undef SSQ
#undef G_WRITE
#undef G_COMPUTE
}
DEVI u32x2 pack4(float a, float b, float c, float d) { u32x2 w; w.x = cvtpk(a, b); w.y = cvtpk(c, d); return w; }

struct EpiIn {
  static constexpr bool PRE = false;
  bf16_t* px; bf16_t* ht; bf16_t* htc;
  template <bool SWAP> DEVI void run(const f32x16 (&acc)[2][2], int m0, int n0, int wm, int wn, int r32, int hi, const float*, const f32x4 (&)[8]) const {
#pragma unroll
    for (int mi = 0; mi < 2; ++mi)
#pragma unroll
      for (int ni = 0; ni < 2; ++ni)
#pragma unroll
        for (int q = 0; q < 4; ++q) {
          const u32x2 w = pack4(acc[mi][ni][4 * q], acc[mi][ni][4 * q + 1], acc[mi][ni][4 * q + 2], acc[mi][ni][4 * q + 3]);
          if (SWAP) { const int m = m0 + wm * 64 + mi * 32 + r32, nb = n0 + wn * 64 + ni * 32 + 8 * q + 4 * hi;
            if (nb < PXW) *(u32x2*)(px + (size_t)m * PXW + nb) = w;
          } else { const int ch = n0 + wn * 64 + ni * 32 + r32 - 2176, mb = m0 + wm * 64 + mi * 32 + 8 * q + 4 * hi;
            if (mb < TL) { const int b = mb >> 13, t = mb & (L - 1); *(u32x2*)(ht + ((size_t)(b * 1024 + ch)) * L + t) = w; }
            else { const int j = mb - TL, b = j >> 8, t = j & 255; *(u32x2*)(htc + ((size_t)(b * 1024 + ch)) * CT + t) = w; } }
        }
  }
};
DEVI void row_to_bk(int m, int& b, int& krow) { if (m < TL) { b = m >> 13; krow = m & (L - 1); } else { const int j = m - TL; b = j >> 8; krow = L + (j & 255); } }
struct EpiQ {
  static constexpr bool PRE = false;
  bf16_t* qa;
  template <bool SWAP> DEVI void run(const f32x16 (&acc)[2][2], int m0, int n0, int wm, int wn, int r32, int hi, const float* rs, const f32x4 (&)[8]) const {
#pragma unroll
    for (int mi = 0; mi < 2; ++mi) { const int ml = wm * 64 + mi * 32 + r32, m = m0 + ml; const float s = rs[ml]; int b, krow; row_to_bk(m, b, krow);
#pragma unroll
      for (int ni = 0; ni < 2; ++ni)
#pragma unroll
        for (int q = 0; q < 4; ++q) { const int nb = n0 + wn * 64 + ni * 32 + 8 * q + 4 * hi;
          if (nb < 576) { const int h = nb / 96, d = nb - h * 96;
            *(u32x2*)(qa + ((size_t)(b * 6 + h) * LK + krow) * 96 + d) = pack4(acc[mi][ni][4 * q] * s, acc[mi][ni][4 * q + 1] * s, acc[mi][ni][4 * q + 2] * s, acc[mi][ni][4 * q + 3] * s); } } }
  }
};
struct EpiKV {
  static constexpr bool PRE = false;
  bf16_t* ka; bf16_t* vta;
  template <bool SWAP> DEVI void run(const f32x16 (&acc)[2][2], int m0, int n0, int wm, int wn, int r32, int hi, const float* rs, const f32x4 (&)[8]) const {
#pragma unroll
    for (int mi = 0; mi < 2; ++mi)
#pragma unroll
      for (int ni = 0; ni < 2; ++ni)
#pragma unroll
        for (int q = 0; q < 4; ++q) {
          if (SWAP) { const int ml = wm * 64 + mi * 32 + r32; const float s = rs[ml]; int b, krow; row_to_bk(m0 + ml, b, krow);
            const int nb = n0 + wn * 64 + ni * 32 + 8 * q + 4 * hi, h = nb >> 6, d = nb & 63;
            *(u32x2*)(ka + ((size_t)(b * 6 + h) * LK + krow) * 96 + d) = pack4(acc[mi][ni][4 * q] * s, acc[mi][ni][4 * q + 1] * s, acc[mi][ni][4 * q + 2] * s, acc[mi][ni][4 * q + 3] * s);
          } else { const int nv = n0 + wn * 64 + ni * 32 + r32 - 384, h = nv >> 6, dv = nv & 63; const int mlb = wm * 64 + mi * 32 + 8 * q + 4 * hi; int b, krow; row_to_bk(m0 + mlb, b, krow);
            *(u32x2*)(vta + ((size_t)(b * 6 + h) * 64 + dv) * LK + krow) = pack4(acc[mi][ni][4 * q] * rs[mlb], acc[mi][ni][4 * q + 1] * rs[mlb + 1], acc[mi][ni][4 * q + 2] * rs[mlb + 2], acc[mi][ni][4 * q + 3] * rs[mlb + 3]); }
        }
  }
};
struct EpiOut {
  static constexpr bool PRE = true;
  const float* xl; const float* xc; float* dl; float* dc; const float* mod;
  DEVI void pre(f32x4 (&xp)[8], int m0, int n0, int wm, int wn, int r32, int hi) const {
    const int m = m0 + wm * 64 + r32; const float* src = m < TL ? xl + (size_t)m * DM : xc + (size_t)(m - TL) * DM;
#pragma unroll
    for (int ni = 0; ni < 2; ++ni)
#pragma unroll
      for (int q = 0; q < 4; ++q) xp[ni * 4 + q] = *(const f32x4*)(src + n0 + wn * 64 + ni * 32 + 8 * q + 4 * hi);
  }
  template <bool SWAP> DEVI void run(const f32x16 (&acc)[2][2], int m0, int n0, int wm, int wn, int r32, int hi, const float*, const f32x4 (&xp)[8]) const {
    f32x4 x1[8];
    { const int m = m0 + wm * 64 + 32 + r32; const float* src = m < TL ? xl + (size_t)m * DM : xc + (size_t)(m - TL) * DM;
#pragma unroll
      for (int ni = 0; ni < 2; ++ni)
#pragma unroll
        for (int q = 0; q < 4; ++q) x1[ni * 4 + q] = *(const f32x4*)(src + n0 + wn * 64 + ni * 32 + 8 * q + 4 * hi); }
#pragma unroll
    for (int mi = 0; mi < 2; ++mi) { const int m = m0 + wm * 64 + mi * 32 + r32;
      float* dst; int v;
      if (m < TL) { dst = dl + (size_t)m * DM; v = m >> 13; } else { dst = dc + (size_t)(m - TL) * DM; v = 4; }
      const float* gt = mod + v * 3072 + 2048;
#pragma unroll
      for (int ni = 0; ni < 2; ++ni)
#pragma unroll
        for (int q = 0; q < 4; ++q) { const int nb = n0 + wn * 64 + ni * 32 + 8 * q + 4 * hi;
          const f32x4 xv = mi == 0 ? xp[ni * 4 + q] : x1[ni * 4 + q], gv = *(const f32x4*)(gt + nb); f32x4 o;
          o[0] = xv[0] + gv[0] * acc[mi][ni][4 * q]; o[1] = xv[1] + gv[1] * acc[mi][ni][4 * q + 1]; o[2] = xv[2] + gv[2] * acc[mi][ni][4 * q + 2]; o[3] = xv[3] + gv[3] * acc[mi][ni][4 * q + 3];
          *(f32x4*)(dst + nb) = o; } }
  }
};

template <int DK> DEVI int kaddr(int row, int chunk) { return DK == 96 ? row * 208 + chunk * 16 : swz128(row, chunk); }
template <int DK> DEVI void qkt(f32x16& p0, f32x16& p1, const char* Ks, const bf16x8* qr, int r32, int hi, float init) {
#pragma unroll
  for (int r = 0; r < 16; ++r) { p0[r] = init; p1[r] = init; }
  constexpr int NQ = DK / 16;
  bf16x8 kf[2 * NQ];
#pragma unroll
  for (int d0 = 0; d0 < 2 && d0 < NQ; ++d0) { kf[2 * d0] = *(const bf16x8*)(Ks + kaddr<DK>(r32, d0 * 2 + hi)); kf[2 * d0 + 1] = *(const bf16x8*)(Ks + kaddr<DK>(32 + r32, d0 * 2 + hi)); }
  __builtin_amdgcn_sched_group_barrier(0x100, 4, 0);
#pragma unroll
  for (int d0 = 0; d0 < NQ; ++d0) {
    if (d0 + 2 < NQ) { kf[2 * (d0 + 2)] = *(const bf16x8*)(Ks + kaddr<DK>(r32, (d0 + 2) * 2 + hi)); kf[2 * (d0 + 2) + 1] = *(const bf16x8*)(Ks + kaddr<DK>(32 + r32, (d0 + 2) * 2 + hi)); }
    p0 = __builtin_amdgcn_mfma_f32_32x32x16_bf16(kf[2 * d0], qr[d0], p0, 0, 0, 0);
    p1 = __builtin_amdgcn_mfma_f32_32x32x16_bf16(kf[2 * d0 + 1], qr[d0], p1, 0, 0, 0);
    __builtin_amdgcn_sched_group_barrier(0x8, 2, 0);
    if (d0 + 2 < NQ) __builtin_amdgcn_sched_group_barrier(0x100, 2, 0);
  }
}
template <bool MASK, bool FIRST>
DEVI void partialSM(f32x16& p0, f32x16& p1, float& M, float& alpha, bool domask, int kp0, int qpos, int hi) {
  constexpr float THR2 = 11.541560327111707f;
  if (MASK) { if (domask) {
#pragma unroll
      for (int r = 0; r < 16; ++r) { const int k0 = kp0 + crow(r, hi), k1 = k0 + 32; int d0 = k0 - qpos, d1 = k1 - qpos; d0 = d0 < 0 ? -d0 : d0; d1 = d1 < 0 ? -d1 : d1;
        if (!(d0 <= 128 && (unsigned)k0 < (unsigned)L)) p0[r] = -1e30f;
        if (!(d1 <= 128 && (unsigned)k1 < (unsigned)L)) p1[r] = -1e30f; } } }
  float pmax = p0[0];
#pragma unroll
  for (int r = 1; r < 16; ++r) pmax = fmaxf(pmax, p0[r]);
#pragma unroll
  for (int r = 0; r < 16; ++r) pmax = fmaxf(pmax, p1[r]);
  { auto rr = __builtin_amdgcn_permlane32_swap(__float_as_uint(pmax), __float_as_uint(pmax), false, false);
    pmax = fmaxf(__uint_as_float(rr[0]), __uint_as_float(rr[1])); }
  if (FIRST) { const float Mn = fmaxf(M, pmax); alpha = __builtin_amdgcn_exp2f(M - Mn); M = Mn;
#pragma unroll
    for (int r = 0; r < 16; ++r) { p0[r] -= Mn; p1[r] -= Mn; }
  } else if (__builtin_expect(__all(pmax <= THR2), 1)) { alpha = 1.f; }
  else { const float d = fmaxf(pmax, 0.f); alpha = __builtin_amdgcn_exp2f(-d); M += d;
#pragma unroll
    for (int r = 0; r < 16; ++r) { p0[r] -= d; p1[r] -= d; } }
#pragma unroll
  for (int r = 0; r < 16; ++r) p0[r] = __builtin_amdgcn_exp2f(p0[r]);
}
DEVI void finishSM(f32x16& p0, f32x16& p1, bf16x8& pa0, bf16x8& pa1, bf16x8& pa2, bf16x8& pa3) {
#pragma unroll
  for (int r = 0; r < 16; ++r) p1[r] = __builtin_amdgcn_exp2f(p1[r]);
#define PK4(Pv, BASE, OUT) do { unsigned a0 = cvtpk(Pv[BASE + 0], Pv[BASE + 1]), a1 = cvtpk(Pv[BASE + 2], Pv[BASE + 3]);   \
    unsigned b0 = cvtpk(Pv[BASE + 4], Pv[BASE + 5]), b1 = cvtpk(Pv[BASE + 6], Pv[BASE + 7]);                              \
    auto r0 = __builtin_amdgcn_permlane32_swap(a0, b0, false, false); auto r1 = __builtin_amdgcn_permlane32_swap(a1, b1, false, false); \
    u32x4 w = {r0[0], r1[0], r0[1], r1[1]}; OUT = *reinterpret_cast<bf16x8*>(&w); } while (0)
  PK4(p0, 0, pa0); PK4(p0, 8, pa1); PK4(p1, 0, pa2); PK4(p1, 8, pa3);
#undef PK4
}
DEVI void pv(f32x16* o, const char* Vs, bf16x8 pa0, bf16x8 pa1, bf16x8 pa2, bf16x8 pa3, int r32, int hi) {
  bf16x8 va[4], vb[4];
#pragma unroll
  for (int ks = 0; ks < 4; ++ks) { va[ks] = *(const bf16x8*)(Vs + swz128(r32, 2 * ks + hi)); vb[ks] = *(const bf16x8*)(Vs + swz128(32 + r32, 2 * ks + hi)); }
  __builtin_amdgcn_sched_group_barrier(0x100, 8, 0);
  const bf16x8 ones = {(short)0x3F80, (short)0x3F80, (short)0x3F80, (short)0x3F80, (short)0x3F80, (short)0x3F80, (short)0x3F80, (short)0x3F80};
  o[2] = __builtin_amdgcn_mfma_f32_32x32x16_bf16(pa0, ones, o[2], 0, 0, 0);
  o[2] = __builtin_amdgcn_mfma_f32_32x32x16_bf16(pa1, ones, o[2], 0, 0, 0);
  o[2] = __builtin_amdgcn_mfma_f32_32x32x16_bf16(pa2, ones, o[2], 0, 0, 0);
  o[2] = __builtin_amdgcn_mfma_f32_32x32x16_bf16(pa3, ones, o[2], 0, 0, 0);
  __builtin_amdgcn_sched_group_barrier(0x8, 4, 0);
  o[0] = __builtin_amdgcn_mfma_f32_32x32x16_bf16(pa0, va[0], o[0], 0, 0, 0);
  o[1] = __builtin_amdgcn_mfma_f32_32x32x16_bf16(pa0, vb[0], o[1], 0, 0, 0);
  o[0] = __builtin_amdgcn_mfma_f32_32x32x16_bf16(pa1, va[1], o[0], 0, 0, 0);
  o[1] = __builtin_amdgcn_mfma_f32_32x32x16_bf16(pa1, vb[1], o[1], 0, 0, 0);
  o[0] = __builtin_amdgcn_mfma_f32_32x32x16_bf16(pa2, va[2], o[0], 0, 0, 0);
  o[1] = __builtin_amdgcn_mfma_f32_32x32x16_bf16(pa2, vb[2], o[1], 0, 0, 0);
  o[0] = __builtin_amdgcn_mfma_f32_32x32x16_bf16(pa3, va[3], o[0], 0, 0, 0);
  o[1] = __builtin_amdgcn_mfma_f32_32x32x16_bf16(pa3, vb[3], o[1], 0, 0, 0);
  __builtin_amdgcn_sched_group_barrier(0x8, 8, 0);
}
DEVI void rope8(bf16x8& a, bf16x8& b, const float2* __restrict__ cs) {
  u32x4 ua = *reinterpret_cast<u32x4*>(&a), ub = *reinterpret_cast<u32x4*>(&b);
#pragma unroll
  for (int q = 0; q < 4; ++q) {
    const f32x4 e = *(const f32x4*)(cs + 2 * q);
    const float x10 = blo(ua[q]), x11 = bhi(ua[q]), x20 = blo(ub[q]), x21 = bhi(ub[q]);
    ua[q] = cvtpk(x10 * e[0] - x20 * e[1], x11 * e[2] - x21 * e[3]);
    ub[q] = cvtpk(x20 * e[0] + x10 * e[1], x21 * e[2] + x11 * e[3]);
  }
  a = *reinterpret_cast<bf16x8*>(&ua); b = *reinterpret_cast<bf16x8*>(&ub);
}
template <int DK, bool MASK>
DEVI void attn_body(char* lds, const bf16_t* __restrict__ Qb, int ldq, const bf16_t* __restrict__ Kh, const bf16_t* __restrict__ Vth, int ldv,
                    int startA, int nA, int startB, int nB, float scale, float m_init, float l_init, int q0, const float2* __restrict__ ropetab,
                    const bf16_t* __restrict__ gate, bf16_t* __restrict__ Yo) {
  constexpr int NQ = DK / 16, CPR = DK / 8, KBUF = 13312, VBUF = 8192;
  int tid_ = threadIdx.x; asm volatile("" : "+v"(tid_));
  const int tid = tid_, wid = tid >> 6, lane = tid & 63, r32 = lane & 31, hi = lane >> 5;
  char* K_lds = lds; char* V_lds = lds + 4 * KBUF; float* wsf = (float*)(lds + 4 * KBUF + 4 * VBUF) + wid * 64; float* al_l = wsf + 32;
  const float C = scale * 1.4426950408889634f;
  float M = m_init * 1.4426950408889634f; f32x16 o[3]; bf16x8 qr[NQ];
#pragma unroll
  for (int r = 0; r < 16; ++r) { o[0][r] = 0.f; o[1][r] = 0.f; o[2][r] = l_init; }
  const int qpos = q0 + wid * 32 + r32;
  const int wv = __builtin_amdgcn_readfirstlane(wid);
  const bool n3 = (DK == 96) && (wv < 5);
  int kofsA, kofsB = 0;
  if (DK == 96) { const int sA = 64 * wv + lane, rA = sA / 13, cA = sA - rA * 13; kofsA = rA * 96 + (cA < 12 ? cA : 0) * 8;
                  const int sB = 64 * (wv + 8) + lane, rB = sB / 13, cB = sB - rB * 13; kofsB = (rB < 64 ? rB : 63) * 96 + (cB < 12 ? cB : 0) * 8; }
  else { const int r_ = 8 * wv + (lane >> 3), c_ = (lane & 7) ^ ((r_ >> 1) & 7); kofsA = r_ * 64 + c_ * 8; }
  size_t vofs; { const int r_ = 8 * wv + (lane >> 3), c_ = (lane & 7) ^ ((r_ >> 1) & 7); vofs = (size_t)r_ * ldv + c_ * 8; }
#define TROW(j) ((j) < nA ? startA + 64 * (j) : startB + 64 * ((j) - nA))
#define GLDS(j, slot) do { const int kr_ = TROW(j); const bf16_t* kb_ = Kh + (size_t)kr_ * DK; \
    __builtin_amdgcn_global_load_lds((const unsigned*)(kb_ + kofsA), (unsigned*)(K_lds + (slot) * KBUF + wv * 1024), 16, 0, 0); \
    if (n3) __builtin_amdgcn_global_load_lds((const unsigned*)(kb_ + kofsB), (unsigned*)(K_lds + (slot) * KBUF + (wv + 8) * 1024), 16, 0, 0); \
    __builtin_amdgcn_global_load_lds((const unsigned*)(Vth + vofs + kr_), (unsigned*)(V_lds + (slot) * VBUF + wv * 1024), 16, 0, 0); } while (0)
#define WAITT(more) do { if (more) { if (n3) asm volatile("s_waitcnt vmcnt(3)" ::: "memory"); else asm volatile("s_waitcnt vmcnt(2)" ::: "memory"); } \
    else asm volatile("s_waitcnt vmcnt(0)" ::: "memory"); \
    asm volatile("s_waitcnt lgkmcnt(0)" ::: "memory"); __builtin_amdgcn_s_barrier(); } while (0)
  GLDS(0, 0); GLDS(1, 1);
  { const bf16_t* Qw = Qb + (size_t)(wid * 32 + r32) * ldq + hi * 8;
#pragma unroll
    for (int d0 = 0; d0 < NQ; ++d0) qr[d0] = *(const bf16x8*)(Qw + d0 * 16);
    if (ropetab) {
      if (DK == 96) rope8(qr[NQ - 2], qr[NQ - 1], ropetab + (size_t)qpos * 16 + hi * 8);
      else { rope8(qr[0], qr[2], ropetab + (size_t)qpos * 32 + hi * 8); rope8(qr[1], qr[3], ropetab + (size_t)qpos * 32 + 16 + hi * 8); }
    }
#pragma unroll
    for (int d0 = 0; d0 < NQ; ++d0) { u32x4 u = *reinterpret_cast<u32x4*>(&qr[d0]);
#pragma unroll
      for (int q = 0; q < 4; ++q) u[q] = cvtpk(blo(u[q]) * C, bhi(u[q]) * C);
      qr[d0] = *reinterpret_cast<bf16x8*>(&u); }
  }
#define RESC(a) do { if (__any((a) < 1.f)) { if (hi == 0) al_l[r32] = (a); asm volatile("s_waitcnt lgkmcnt(0)" ::: "memory"); \
    _Pragma("unroll") for (int r = 0; r < 16; ++r) { const float f_ = al_l[crow(r, hi)]; o[0][r] *= f_; o[1][r] *= f_; o[2][r] *= f_; } } } while (0)
  const int qw = q0 + wv * 32;
#define KP0(j) (TROW(j) - 128)
#define TSKIP(j) (MASK && (j) < nA && (KP0(j) + 63 < qw - 128 || KP0(j) > qw + 159 || KP0(j) + 63 < 0 || KP0(j) >= L))
#define TMASK(j) (MASK && (j) < nA && !(KP0(j) >= qw - 97 && KP0(j) + 63 <= qw + 128 && KP0(j) >= 0 && KP0(j) + 63 < L))
#define PSM(p0, p1, al, j) partialSM<MASK, false>(p0, p1, M, al, TMASK(j), KP0(j), qpos, hi)
  f32x16 pA0, pA1, pB0, pB1; float alA, alB; bf16x8 pa0, pa1, pa2, pa3; const int NT = nA + nB;
  unsigned gq[2][16];
#define ITER(j, PX0, PX1, ALX, SKX, PW0, PW1, SKW, KS, VS, NS) do { WAITT((j) + 1 < NT); if ((j) + 2 < NT) GLDS((j) + 2, NS); \
    SKX = TSKIP(j); \
    if (!SKX) qkt<DK>(PX0, PX1, K_lds + (KS) * KBUF, qr, r32, hi, -M); \
    if (!SKW) { finishSM(PW0, PW1, pa0, pa1, pa2, pa3); pv(o, V_lds + (VS) * VBUF, pa0, pa1, pa2, pa3, r32, hi); } \
    if (!SKX) { PSM(PX0, PX1, ALX, j); RESC(ALX); } } while (0)
  bool skA = false, skB = false;
  WAITT(true); GLDS(2, 2);
  skA = TSKIP(0);
  if (!skA) { qkt<DK>(pA0, pA1, K_lds, qr, r32, hi, 0.f); partialSM<MASK, true>(pA0, pA1, M, alA, TMASK(0), KP0(0), qpos, hi);
    RESC(alA); }
  int jb = 0;
  for (; jb + 4 < NT; jb += 4) {
    ITER(jb + 1, pB0, pB1, alB, skB, pA0, pA1, skA, 1, 0, 3);
    ITER(jb + 2, pA0, pA1, alA, skA, pB0, pB1, skB, 2, 1, 0);
    ITER(jb + 3, pB0, pB1, alB, skB, pA0, pA1, skA, 3, 2, 1);
    ITER(jb + 4, pA0, pA1, alA, skA, pB0, pB1, skB, 0, 3, 2);
  }
  ITER(jb + 1, pB0, pB1, alB, skB, pA0, pA1, skA, 1, 0, 3);
  ITER(jb + 2, pA0, pA1, alA, skA, pB0, pB1, skB, 2, 1, 0);
  WAITT(false);
#pragma unroll
  for (int r = 0; r < 16; ++r) { const size_t go = (size_t)(wid * 32 + crow(r, hi)) * PXW + r32; gq[0][r] = gate[go]; gq[1][r] = gate[go + 32]; }
  __builtin_amdgcn_sched_barrier(0);
  skB = TSKIP(NT - 1);
  if (!skB) qkt<DK>(pB0, pB1, K_lds + 3 * KBUF, qr, r32, hi, -M);
  if (!skA) { finishSM(pA0, pA1, pa0, pa1, pa2, pa3); pv(o, V_lds + 2 * VBUF, pa0, pa1, pa2, pa3, r32, hi); }
  if (!skB) { PSM(pB0, pB1, alB, NT - 1); RESC(alB);
    finishSM(pB0, pB1, pa0, pa1, pa2, pa3); pv(o, V_lds + 3 * VBUF, pa0, pa1, pa2, pa3, r32, hi); }
#pragma unroll
  for (int r = 0; r < 16; ++r) { const int orow = wid * 32 + crow(r, hi); const float rl = __builtin_amdgcn_rcpf(o[2][r]);
#pragma unroll
    for (int d0 = 0; d0 < 2; ++d0) { const int col = d0 * 32 + r32; const float gv = __uint_as_float(gq[d0][r] << 16);
      Yo[(size_t)orow * 1024 + col] = f2bf(o[d0][r] * rl * silu(gv)); } }
  __syncthreads();
#undef KP0
#undef TSKIP
#undef TMASK
#undef TROW
#undef GLDS
#undef WAITT
#undef ITER
#undef RESC
#undef PSM
}

DEVI float2 cmul(float2 a, float2 b) { return make_float2(a.x * b.x - a.y * b.y, a.x * b.y + a.y * b.x); }
DEVI float2 cmulc(float2 a, float2 w) { return make_float2(a.x * w.x + a.y * w.y, a.y * w.x - a.x * w.y); }
DEVI void fft_fwd(float2* x, const float2* __restrict__, int tid) {
  for (int shp = 12; shp >= 0; shp -= 2) { const int sp = 1 << shp; const float inv4s = 0.25f / (float)sp;
#pragma unroll 2
    for (int u = 0; u < 8; ++u) { const int q = tid + 512 * u, pos = q & (sp - 1), i0 = ((q >> shp) << (shp + 2)) | pos;
      const float2 e0 = x[i0], e1 = x[i0 + sp], e2 = x[i0 + 2 * sp], e3 = x[i0 + 3 * sp];
      const float fr = (float)pos * inv4s;
      const float2 wA0 = make_float2(__builtin_amdgcn_cosf(fr), -__builtin_amdgcn_sinf(fr)), wA1 = make_float2(wA0.y, -wA0.x), wB = cmul(wA0, wA0);
      const float2 t0 = make_float2(e0.x + e2.x, e0.y + e2.y), t2 = cmul(make_float2(e0.x - e2.x, e0.y - e2.y), wA0);
      const float2 t1 = make_float2(e1.x + e3.x, e1.y + e3.y), t3 = cmul(make_float2(e1.x - e3.x, e1.y - e3.y), wA1);
      x[i0] = make_float2(t0.x + t1.x, t0.y + t1.y); x[i0 + sp] = cmul(make_float2(t0.x - t1.x, t0.y - t1.y), wB);
      x[i0 + 2 * sp] = make_float2(t2.x + t3.x, t2.y + t3.y); x[i0 + 3 * sp] = cmul(make_float2(t2.x - t3.x, t2.y - t3.y), wB); }
    __syncthreads(); }
}
DEVI void fft_inv(float2* x, const float2* __restrict__, int tid) {
  for (int shp = 0; shp <= 12; shp += 2) { const int sp = 1 << shp; const float inv4s = 0.25f / (float)sp;
#pragma unroll 2
    for (int u = 0; u < 8; ++u) { const int q = tid + 512 * u, pos = q & (sp - 1), i0 = ((q >> shp) << (shp + 2)) | pos;
      const float2 e0 = x[i0], e1 = x[i0 + sp], e2 = x[i0 + 2 * sp], e3 = x[i0 + 3 * sp];
      const float fr = (float)pos * inv4s;
      const float2 wA0 = make_float2(__builtin_amdgcn_cosf(fr), -__builtin_amdgcn_sinf(fr)), wA1 = make_float2(wA0.y, -wA0.x), wB = cmul(wA0, wA0);
      const float2 b1 = cmulc(e1, wB), b3 = cmulc(e3, wB);
      const float2 t0 = make_float2(e0.x + b1.x, e0.y + b1.y), t1 = make_float2(e0.x - b1.x, e0.y - b1.y);
      const float2 t2 = make_float2(e2.x + b3.x, e2.y + b3.y), t3 = make_float2(e2.x - b3.x, e2.y - b3.y);
      const float2 c2 = cmulc(t2, wA0), c3 = cmulc(t3, wA1);
      x[i0] = make_float2(t0.x + c2.x, t0.y + c2.y); x[i0 + 2 * sp] = make_float2(t0.x - c2.x, t0.y - c2.y);
      x[i0 + sp] = make_float2(t1.x + c3.x, t1.y + c3.y); x[i0 + 3 * sp] = make_float2(t1.x - c3.x, t1.y - c3.y); }
    __syncthreads(); }
}
DEVI float block_sum(float v, float* red, int tid) {
  v = wave_sum(v); __syncthreads(); if ((tid & 63) == 0) red[tid >> 6] = v; __syncthreads();
  float t = 0.f;
#pragma unroll
  for (int i = 0; i < 8; ++i) t += red[i];
  __syncthreads(); return t;
}
DEVI float sconv(const bf16_t* __restrict__ u, int t, int len, float w0, float w1, float w2, float b) {
  const float um = t > 0 ? bf2f(u[t - 1]) : 0.f, uc = bf2f(u[t]), up = t + 1 < len ? bf2f(u[t + 1]) : 0.f;
  return um * w0 + uc * w1 + up * w2 + b;
}

DEVI void gbar(unsigned* ctr, unsigned& gen) {
  asm volatile("s_waitcnt vmcnt(0)" ::: "memory");
  __syncthreads();
  gen += 1u;
  if (threadIdx.x < 64) {
    const unsigned lane = threadIdx.x, G = gridDim.x;
    if (lane == 0) {
      __builtin_amdgcn_fence(__ATOMIC_RELEASE, "agent");
      asm volatile("s_waitcnt vmcnt(0)" ::: "memory");
      __hip_atomic_fetch_add(ctr + (blockIdx.x & 7u) * 64u, 1u, __ATOMIC_RELAXED, __HIP_MEMORY_SCOPE_AGENT);
    }
    const unsigned want = lane < 8u ? gen * ((G + 7u - lane) >> 3) : 0u;
    for (;;) { const unsigned v = lane < 8u ? __hip_atomic_load(ctr + lane * 64u, __ATOMIC_RELAXED, __HIP_MEMORY_SCOPE_AGENT) : 0u;
      if (__all(v >= want)) break; __builtin_amdgcn_s_sleep(1); }
    if (lane == 0) {
      __builtin_amdgcn_fence(__ATOMIC_ACQUIRE, "agent");
      asm volatile("s_waitcnt vmcnt(0)" ::: "memory");
    }
  }
  __syncthreads();
}
DEVI void sconv8(const bf16_t* __restrict__ u, int t0, int len, int lane, float w0, float w1, float w2, float b, float (&out)[8]) {
  const u32x4 v = *(const u32x4*)(u + t0);
  float e[10];
  e[1] = blo(v[0]); e[2] = bhi(v[0]); e[3] = blo(v[1]); e[4] = bhi(v[1]); e[5] = blo(v[2]); e[6] = bhi(v[2]); e[7] = blo(v[3]); e[8] = bhi(v[3]);
  float prev = __shfl_up(e[8], 1), next = __shfl_down(e[1], 1);
  if (lane == 0) prev = t0 > 0 ? bf2f(u[t0 - 1]) : 0.f;
  if (lane == 63) next = t0 + 8 < len ? bf2f(u[t0 + 8]) : 0.f;
  e[0] = prev; e[9] = next;
#pragma unroll
  for (int j = 0; j < 8; ++j) out[j] = e[j] * w0 + e[j + 1] * w1 + e[j + 2] * w2 + b;
}
typedef const __attribute__((address_space(4))) P* PKP;
__global__ void __launch_bounds__(512) mega(P p_arg) {
  PKP pk = (PKP)__builtin_amdgcn_kernarg_segment_ptr();
#define p (*pk)
  __shared__ __attribute__((aligned(16))) char lds[149504];
  cg::grid_group grid = cg::this_grid();
  int tid = threadIdx.x; int wid = tid >> 6, lane = tid & 63;
#define RETID() do { tid = threadIdx.x; asm volatile("" : "+v"(tid)); wid = tid >> 6; lane = tid & 63; } while (0)
  const int G = gridDim.x, bid = blockIdx.x;
  char* ws = p.ws;
#define WIN ((bf16_t*)(ws + OFF_WIN))
#define WUQ ((bf16_t*)(ws + OFF_WUQ))
#define WUKV ((bf16_t*)(ws + OFF_WUKV))
#define WOUT ((bf16_t*)(ws + OFF_WOUT))
#define MOD ((float*)(ws + OFF_MOD))
#define TW ((float2*)(ws + OFF_TW))
#define PSUM ((float*)(ws + OFF_PSUM))
#define HKC ((float*)(ws + OFF_HKC))
#define ROPEM ((float2*)(ws + OFF_RPM))
#define ROPES ((float2*)(ws + OFF_RPS))
#define XC ((float*)(ws + OFF_XC))
#define KF ((float2*)(ws + OFF_KF))
#define H ((bf16_t*)(ws + OFF_H))
#define PX ((bf16_t*)(ws + OFF_PX))
#define HT ((bf16_t*)(ws + OFF_HT))
#define HTC ((bf16_t*)(ws + OFF_HTC))
#define QA ((bf16_t*)(ws + OFF_QA))
#define KA ((bf16_t*)(ws + OFF_KA))
#define VTA ((bf16_t*)(ws + OFF_VTA))
#define KS ((bf16_t*)(ws + OFF_KS))
#define VS ((bf16_t*)(ws + OFF_VS))
#define Y ((bf16_t*)(ws + OFF_Y))
#define YHT ((bf16_t*)(ws + OFF_YHT))
#define YHTC ((bf16_t*)(ws + OFF_YHTC))
#define HKT ((float*)(ws + OFF_HKT))
#define REWS() do { asm volatile("" : "+s"(pk)); ws = p.ws; } while (0)
#ifndef PHM
#define PHM 0xffff
#endif
#ifndef REP_P0
#define REP_P0 1
#endif
#ifndef REP_D
#define REP_D 1
#endif
#ifndef REP_B
#define REP_B 1
#endif
#ifndef REP_C
#define REP_C 1
#endif
#ifndef REP_MLA
#define REP_MLA 1
#endif
#ifndef REP_SWA
#define REP_SWA 1
#endif
#ifndef REP_HY
#define REP_HY 1
#endif
#ifndef REP_A
#define REP_A 1
#endif
#ifndef REP_E0
#define REP_E0 1
#endif
#ifndef REP_KF
#define REP_KF 1
#endif
#ifndef REP_D2
#define REP_D2 1
#endif
  REWS();
  unsigned bar_target = 0u;
  if (bid == 0 && tid < 8) __hip_atomic_store((unsigned*)(ws + OFF_BAR) + tid * 64, 0u, __ATOMIC_RELAXED, __HIP_MEMORY_SCOPE_AGENT);
  grid.sync();
#define GSYNC() gbar((unsigned*)(ws + OFF_BAR), bar_target)
  for (int rep = 0; rep < REP_P0; ++rep) {
  if (PHM & 1) {
    constexpr int N_WIN = 2 * 16 * 49, N_WUQ = 2 * 6 * 9, N_WUKV = 2 * 4 * 12, N_WOUT = 2 * 16 * 16, N_MOD = 96, N_HF = 2 * 512, N_HFC = 16, N_MISC = 1 + 64;
    constexpr int E1 = N_WIN, E2 = E1 + N_WUQ, E3 = E2 + N_WUKV, E4 = E3 + N_WOUT, E5 = E4 + N_MOD, E6 = E5 + N_HF, E7 = E6 + N_HFC, E8 = E7 + N_MISC;
    for (int it = bid; it < E8; it += G) {
      __syncthreads(); RETID();
      if (it < E4) {
        const float* src; bf16_t* dst; int K, N, kt, nt, mode, l; const float* kscale = nullptr;
        if (it < E1) { int r = it; l = r / (16 * 49); r -= l * 16 * 49; kt = r / 49; nt = r - kt * 49; K = 1024; N = 3104; src = p.w_in + (size_t)l * K * N; dst = WIN + (size_t)l * NIN * 1024; mode = 0; }
        else if (it < E2) { int r = it - E1; l = r / 54; r -= l * 54; kt = r / 9; nt = r - kt * 9; K = 384; N = 576; src = p.w_uq + (size_t)l * K * N; dst = WUQ + (size_t)l * 576 * 384; mode = 1; kscale = p.q_norm + l * 384; }
        else if (it < E3) { int r = it - E2; l = r / 48; r -= l * 48; kt = r / 12; nt = r - kt * 12; K = 256; N = 768; src = p.w_ukv + (size_t)l * K * N; dst = WUKV + (size_t)l * 768 * 256; mode = 2; kscale = p.kv_norm + l * 256; }
        else { int r = it - E3; l = r / 256; r -= l * 256; kt = r / 16; nt = r - kt * 16; K = 1024; N = 1024; src = p.w_out + (size_t)l * K * N; dst = WOUT + (size_t)l * 1024 * 1024; mode = 1; }
        float* tile = (float*)lds;
        { const int kk = tid >> 4, nq = tid & 15;
#pragma unroll
          for (int i = 0; i < 2; ++i) { const int k = kt * 64 + kk + 32 * i, n = nt * 64 + nq * 4;
            f32x4 v = {0.f, 0.f, 0.f, 0.f}; if (n < N) v = *(const f32x4*)(src + (size_t)k * N + n);
            const float sc = kscale ? kscale[k] : 1.f;
            float* tp = tile + (kk + 32 * i) * 65 + nq * 4; tp[0] = v[0] * sc; tp[1] = v[1] * sc; tp[2] = v[2] * sc; tp[3] = v[3] * sc; } }
        __syncthreads();
        { const int nl = tid >> 3, kc = tid & 7, n = nt * 64 + nl;
          if (n < N) { int np = n; if (mode == 0) np = n < 2080 ? n : n + 96; else if (mode == 2) { const int h = n >> 7, d = n & 127; np = d < 64 ? h * 64 + d : 384 + h * 64 + (d - 64); }
            const float* tp = tile + (kc * 8) * 65 + nl; u32x4 w;
            w[0] = cvtpk(tp[0], tp[65]); w[1] = cvtpk(tp[130], tp[195]); w[2] = cvtpk(tp[260], tp[325]); w[3] = cvtpk(tp[390], tp[455]);
            *(u32x4*)(dst + (size_t)np * K + kt * 64 + kc * 8) = w; } }
      } else if (it < E5) {
        const int r = it - E4, l = r / 48, n0 = (r - l * 48) * 64;
        float* sl = (float*)lds; float* red = sl + 5 * 1024;
        for (int i = tid; i < 5 * 1024; i += 512) { const int v = i >> 10, k = i & 1023; const float cv = v < 4 ? p.c[v * 1024 + k] : p.c_ctx[k]; sl[i] = silu(cv); }
        __syncthreads();
        const int kq = tid >> 6, col = tid & 63; float a0 = 0.f, a1 = 0.f, a2 = 0.f, a3 = 0.f, a4 = 0.f;
        const float* wp = p.mod_w + (size_t)l * 1024 * 3072 + n0 + col;
        for (int k = kq * 128; k < kq * 128 + 128; ++k) { const float w = wp[(size_t)k * 3072];
          a0 += sl[k] * w; a1 += sl[1024 + k] * w; a2 += sl[2048 + k] * w; a3 += sl[3072 + k] * w; a4 += sl[4096 + k] * w; }
        red[(kq * 5 + 0) * 64 + col] = a0; red[(kq * 5 + 1) * 64 + col] = a1; red[(kq * 5 + 2) * 64 + col] = a2; red[(kq * 5 + 3) * 64 + col] = a3; red[(kq * 5 + 4) * 64 + col] = a4;
        __syncthreads();
        if (tid < 320) { const int v = tid >> 6, cc = tid & 63; float s = p.mod_b[l * 3072 + n0 + cc];
#pragma unroll
          for (int q = 0; q < 8; ++q) s += red[(q * 5 + v) * 64 + cc];
          MOD[(l * 5 + v) * 3072 + n0 + cc] = s; }
      } else if (it < E7) {
        int l, Lf, t0; float* dstT; float* ps;
        if (it < E6) { const int r = it - E5; l = r >> 9; Lf = L; t0 = (r & 511) * 16; dstT = HKT + (size_t)l * 512 * L; ps = PSUM + ((size_t)l * 512 + (r & 511)) * 512; }
        else { l = 0; Lf = CT; t0 = (it - E6) * 16; dstT = HKC; ps = nullptr; }
        float* zin = (float*)lds; float* h1 = zin + 16 * 17; float* h2 = h1 + 16 * 64;
        if (tid < 16 * 17) { const int tt = tid / 17, e = tid - tt * 17; const int i = t0 + tt; const float tv = (float)i / (float)(Lf - 1), w = (6.283185307179586f / (float)Lf) * (float)i;
          float v; if (e == 0) v = tv; else { const int k = (e - 1) & 7; const float band = 1e-4f + (float)k * ((7.f - 1e-4f) / 7.f); float s, c; sincosf(band * w, &s, &c); v = e <= 8 ? c : -s; }
          zin[tid] = v; }
        __syncthreads();
        for (int idx = tid; idx < 1024; idx += 512) { const int tt = idx >> 6, j = idx & 63; float a = p.hb1[l * 64 + j];
          for (int e = 0; e < 17; ++e) a += zin[tt * 17 + e] * p.hw1[(l * 17 + e) * 64 + j];
          h1[idx] = sinf(p.hfreq[l * 64 + j] * a); }
        __syncthreads();
        for (int idx = tid; idx < 1024; idx += 512) { const int tt = idx >> 6, j = idx & 63; float a = p.hb2[l * 64 + j];
          for (int k = 0; k < 64; ++k) a += h1[tt * 64 + k] * p.hw2[(l * 64 + k) * 64 + j];
          h2[idx] = sinf(p.hfreq[l * 64 + j] * a); }
        __syncthreads();
        { const int n = tid, c = n & 255; float a[16]; const float b3 = p.hb3[l * 512 + n];
#pragma unroll
          for (int tt = 0; tt < 16; ++tt) a[tt] = b3;
          for (int k = 0; k < 64; ++k) { const float w = p.hw3[(l * 64 + k) * 512 + n];
#pragma unroll
            for (int tt = 0; tt < 16; ++tt) a[tt] += h2[tt * 64 + k] * w; }
          const float fast = -15.350567286626973f, slow = -3.0701134573253945f; const float delta = fabsf(fast + (float)c * ((slow - fast) / 255.f));
          float asum = 0.f;
#pragma unroll
          for (int tt = 0; tt < 16; ++tt) { const int i = t0 + tt; const float tv = (float)i / (float)(Lf - 1); a[tt] *= __expf(-tv * delta); if (!(n >= 256 && i == 0)) asum += fabsf(a[tt]); }
          float* dp = dstT + (size_t)n * Lf + t0;
#pragma unroll
          for (int q = 0; q < 4; ++q) { f32x4 v = {a[4 * q], a[4 * q + 1], a[4 * q + 2], a[4 * q + 3]}; *(f32x4*)(dp + 4 * q) = v; }
          if (ps) ps[n] = asum; }
      } else if (it > E7) {
        const int t0 = (it - E7 - 1) * 128;
        for (int i = tid; i < 128 * 48; i += 512) { const int t = t0 + i / 48, e = i % 48; const float prow = (float)(t >> 6), pcol = (float)(t & 63);
          float ang; if (e < 16) ang = (e < 8 ? prow : pcol) * exp2f(-(float)(e & 7) * 0.125f * 13.287712379549449f);
          else { const int k = e - 16; ang = (k < 16 ? prow : pcol) * exp2f(-(float)(k & 15) * 0.0625f * 13.287712379549449f); }
          float sn, cs; sincosf(ang, &sn, &cs);
          if (e < 16) ROPEM[(size_t)t * 16 + e] = make_float2(cs, sn); else ROPES[(size_t)t * 32 + e - 16] = make_float2(cs, sn); }
      } else {
        for (int k = tid; k < 8192; k += 512) { float s, c; sincospif((float)k * (1.f / 8192.f), &s, &c); TW[k] = make_float2(c, -s); }
        const u32x4 z = {0u, 0u, 0u, 0u};
        for (int i = tid; i < 2 * 96 * 128; i += 512) { const int l = i / (96 * 128), r = i - l * 96 * 128; *(u32x4*)(WIN + ((size_t)l * NIN + 2080) * 1024 + (size_t)r * 8) = z; }
        for (int i = tid; i < 8 * 2 * 128 * 8; i += 512) { const int bg = i >> 11, r = i & 2047, row = (r >> 3) & 127, half = r >> 10, ch = r & 7;
          *(u32x4*)(KS + ((size_t)bg * LKS + (half ? 8320 : 0) + row) * 64 + ch * 8) = z; }
        for (int i = tid; i < 8 * 64 * 2 * 16; i += 512) { const int rowi = i >> 5, r = i & 31, half = r >> 4, ch = r & 15;
          *(u32x4*)(VS + (size_t)rowi * LKS + (half ? 8320 : 0) + ch * 8) = z; }
      }
    }
  }
  GSYNC(); }

  for (int l = 0; l < 2; ++l) {
    const float* xl = l == 0 ? p.x : p.out; const float* xc = l == 0 ? p.ctx : XC;
    const float* modl = MOD + l * 5 * 3072;
    REWS();
    for (int rep = 0; rep < REP_KF; ++rep) if (l == 0 && (PHM & 2)) {
      for (int it = bid; it < 512; it += G) { const int ll = it >> 8, c = it & 255;
        __syncthreads(); RETID();
        float2* x = (float2*)lds; float* red = (float*)(lds + 131072);
        const float part = PSUM[((size_t)ll * 512 + tid) * 512 + c] + PSUM[((size_t)ll * 512 + tid) * 512 + 256 + c];
        const float inv = 1.f / (block_sum(part, red, tid) + EPS);
        const float* hf = HKT + ((size_t)ll * 512 + c) * L; const float* hb = HKT + ((size_t)ll * 512 + 256 + c) * L;
#pragma unroll 8
        for (int u = 0; u < 32; ++u) { const int i = tid + 512 * u; float v;
          if (i < L) v = hf[i] * inv; else if (i == L) v = 0.f; else v = hb[2 * L - i] * inv;
          x[i] = make_float2(v, 0.f); }
        __syncthreads();
        fft_fwd(x, TW, tid);
        float2* kf = KF + ((size_t)ll * 256 + c) * NFFT;
        for (int u = 0; u < 32; ++u) { const int i = tid + 512 * u; const float2 v = x[i]; kf[i] = make_float2(v.x * (1.f / NFFT), v.y * (1.f / NFFT)); }
      }
    }
    RETID();
    for (int rep = 0; rep < REP_A; ++rep) if (PHM & 4) for (int row = bid * 8 + wid; row < TA; row += G * 8) {
      const float* src; int v; if (row < TL) { src = xl + (size_t)row * DM; v = row >> 13; } else { src = xc + (size_t)(row - TL) * DM; v = 4; }
      f32x4 a[4]; float ss = 0.f;
#pragma unroll
      for (int i = 0; i < 4; ++i) { a[i] = *(const f32x4*)(src + 4 * (lane + 64 * i)); ss += a[i][0] * a[i][0] + a[i][1] * a[i][1] + a[i][2] * a[i][2] + a[i][3] * a[i][3]; }
      ss = wave_sum(ss); const float rstd = rsqrtf(ss * (1.f / DM) + EPS);
      const float* mv = modl + v * 3072;
#pragma unroll
      for (int i = 0; i < 4; ++i) { const int col = 4 * (lane + 64 * i);
        const f32x4 g = *(const f32x4*)(p.norm_g + l * DM + col), sh = *(const f32x4*)(mv + col), sc = *(const f32x4*)(mv + 1024 + col);
        *(u32x2*)(H + (size_t)row * DM + col) = pack4(a[i][0] * rstd * g[0] * (1.f + sc[0]) + sh[0], a[i][1] * rstd * g[1] * (1.f + sc[1]) + sh[1],
                                                      a[i][2] * rstd * g[2] * (1.f + sc[2]) + sh[2], a[i][3] * rstd * g[3] * (1.f + sc[3]) + sh[3]); }
    }
    GSYNC();

    REWS();
    for (int rep = 0; rep < REP_B; ++rep) if (PHM & 8) {
      GArgs g{H, DM, WIN + (size_t)l * NIN * 1024, 1024, NIN, nullptr, 0}; EpiIn e{PX, HT, HTC};
      constexpr int NM = TA / 256, NN = NIN / 128, NTILES = NM * NN;
      if (G == 256) {
        const int xcd = bid & 7, slot = bid >> 3, cnt = (NTILES + 7 - xcd) >> 3, base = xcd * (NTILES >> 3) + (xcd < (NTILES & 7) ? xcd : (NTILES & 7));
        for (int seq = slot; seq < cnt; seq += 32) { const int lin = base + seq;
          const int mg = lin / (4 * NN), rem = lin - mg * 4 * NN, n = rem >> 2, m = mg * 4 + (rem & 3);
          if (n < 17) gemm_tile<2, false, true>(lds, g, m * 256, n * 128, e); else gemm_tile<2, false, false>(lds, g, m * 256, n * 128, e); }
      } else for (int it = bid; it < NTILES; it += G) { const int mg = it / (4 * NN), rem = it - mg * 4 * NN, n = rem >> 2, m = mg * 4 + (rem & 3);
          if (n < 17) gemm_tile<2, false, true>(lds, g, m * 256, n * 128, e); else gemm_tile<2, false, false>(lds, g, m * 256, n * 128, e); }
    }
    GSYNC();

    REWS();
    for (int rep = 0; rep < REP_C; ++rep) {
      constexpr int NM = TA / 256;
      constexpr int N1 = NM * 5, N2 = N1 + NM * 3, N3 = N2 + NM * 3, N4 = N3 + 264;
      for (int it0 = bid; it0 < N4; it0 += G) {
        if (it0 < N1) { const int m = it0 / 5, n = it0 - m * 5;
          GArgs g{PX + C_MQ, PXW, WUQ + (size_t)l * 576 * 384, 384, 576, nullptr, 0}; EpiQ e{QA};
          gemm_tile<0, true, true>(lds, g, m * 256, n * 128, e); continue; }
        if (it0 < N2) { const int r = it0 - N1, m = r / 3, n = r - m * 3;
          GArgs g{PX + C_MKV, PXW, WUKV + (size_t)l * 768 * 256, 256, 768, nullptr, 0}; EpiKV e{KA, VTA};
          gemm_tile<0, true, true>(lds, g, m * 256, n * 128, e); continue; }
        if (it0 < N3) { const int r = it0 - N2, m = r / 3, n = 3 + r - m * 3;
          GArgs g{PX + C_MKV, PXW, WUKV + (size_t)l * 768 * 256, 256, 768, nullptr, 0}; EpiKV e{KA, VTA};
          gemm_tile<0, true, false>(lds, g, m * 256, n * 128, e); continue; }
        const int it = it0 - N3; {
        const int r0 = it * 128; RETID();
#pragma unroll
        for (int rr = tid >> 4; rr < 128; rr += 32) { const int m = r0 + rr, i = tid & 15; int b, krow; row_to_bk(m, b, krow);
          float x1 = bf2f(PX[(size_t)m * PXW + C_MKR + i]), x2 = bf2f(PX[(size_t)m * PXW + C_MKR + 16 + i]);
          if (m < TL) { const float2 cs = ROPEM[(size_t)krow * 16 + i]; const float y1 = x1 * cs.x - x2 * cs.y, y2 = x2 * cs.x + x1 * cs.y; x1 = y1; x2 = y2; }
          const bf16_t o1 = f2bf(x1), o2 = f2bf(x2);
#pragma unroll
          for (int h = 0; h < 6; ++h) { bf16_t* d = KA + ((size_t)(b * 6 + h) * LK + krow) * 96 + 64; d[i] = o1; d[16 + i] = o2; } }
#pragma unroll 8
        for (int rr = tid >> 6; rr < 128; rr += 8) { const int m = r0 + rr, gi = (tid >> 5) & 1, i = tid & 31; int b, krow; row_to_bk(m, b, krow);
          float x1 = bf2f(PX[(size_t)m * PXW + C_SK + gi * 64 + i]), x2 = bf2f(PX[(size_t)m * PXW + C_SK + gi * 64 + 32 + i]);
          int srow;
          if (m < TL) { const float2 cs = ROPES[(size_t)krow * 32 + i]; const float y1 = x1 * cs.x - x2 * cs.y, y2 = x2 * cs.x + x1 * cs.y; x1 = y1; x2 = y2; srow = 128 + krow; }
          else srow = 8448 + (krow - L);
          bf16_t* d = KS + ((size_t)(b * 2 + gi) * LKS + srow) * 64; d[i] = f2bf(x1); d[32 + i] = f2bf(x2); }
#pragma unroll
        for (int cc = tid >> 7; cc < 16; cc += 4) { const int gd = tid & 127, m = r0 + cc * 8; int b, krow; row_to_bk(m, b, krow);
          const int srow = m < TL ? 128 + krow : 8448 + (krow - L);
          const bf16_t* sp = PX + (size_t)m * PXW + C_SV + gd;
          const unsigned v0 = sp[0], v1 = sp[PXW], v2 = sp[2 * PXW], v3 = sp[3 * PXW], v4 = sp[4 * PXW], v5 = sp[5 * PXW], v6 = sp[6 * PXW], v7 = sp[7 * PXW];
          u32x4 w; w[0] = v0 | (v1 << 16); w[1] = v2 | (v3 << 16); w[2] = v4 | (v5 << 16); w[3] = v6 | (v7 << 16);
          *(u32x4*)(VS + ((size_t)(b * 2 + (gd >> 6)) * 64 + (gd & 63)) * LKS + srow) = w; }
        } }
    }
    GSYNC();

    REWS();
    for (int rep = 0; rep < REP_D; ++rep) {
      const float sc_mla = 0.10206207261596577f, sc_swa = 0.125f;
      for (int rep2 = 0; rep2 < REP_MLA; ++rep2) if (PHM & 256) for (int it = bid; it < (l == 0 ? 792 : 768); it += G) {
        int bh, qb; const bool isctx = it >= 768;
        if (!isctx) { const int round = it >> 8, within = it & 255; bh = round * 8 + (within & 7); qb = within >> 3; } else { bh = it - 768; qb = 0; }
        const int b = bh / 6, h = bh - b * 6, q0 = qb * 256, tok0 = isctx ? TL + b * CT : b * L + q0;
        attn_body<96, false>(lds, QA + ((size_t)bh * LK + (isctx ? L : q0)) * 96, 96, KA + (size_t)bh * LK * 96, VTA + (size_t)bh * 64 * LK, LK,
                             isctx ? L : 0, isctx ? 4 : 132, 0, 0, sc_mla, -1e30f, 0.f, q0, isctx ? nullptr : ROPEM,
                             PX + (size_t)tok0 * PXW + C_MG + h * 64, Y + (size_t)tok0 * 1024 + h * 64);
      }
      for (int rep2 = 0; rep2 < REP_SWA; ++rep2) if (PHM & 512) for (int it = bid; it < (l == 0 ? 816 : 768); it += G) {
        if (it >= 768 && it < 792) continue;
        int bh, qb; const bool isctx = it >= 792;
        if (!isctx) { const int round = it >> 8, within = it & 255; bh = round * 8 + (within & 7); qb = within >> 3; } else { bh = it - 792; qb = 0; }
        const int b = bh / 6, h = bh - b * 6, gi = h / 3, q0 = qb * 256, tok0 = isctx ? TL + b * CT : b * L + q0;
        attn_body<64, true>(lds, PX + (size_t)tok0 * PXW + C_SQ + h * 64, PXW, KS + (size_t)(b * 2 + gi) * LKS * 64, VS + (size_t)(b * 2 + gi) * 64 * LKS, LKS,
                            q0, isctx ? 0 : 8, 8448, 4, sc_swa, p.sink[l * 6 + h], 1.f, q0, isctx ? nullptr : ROPES,
                            PX + (size_t)tok0 * PXW + C_SG + h * 64, Y + (size_t)tok0 * 1024 + 384 + h * 64);
      }
      for (int rep2 = 0; rep2 < REP_HY; ++rep2) if (PHM & 1024) for (int it = bid; it < 512; it += G) {
        __syncthreads(); RETID();
        const int c = it >> 1, bp = it & 1;
        float2* x = (float2*)lds;
        const float* cw = p.conv_w + l * 3 * 768; const float* cb = p.conv_b + l * 768;
        const float w10 = cw[256 + c], w11 = cw[768 + 256 + c], w12 = cw[1536 + 256 + c], b1 = cb[256 + c];
        const float w20 = cw[512 + c], w21 = cw[768 + 512 + c], w22 = cw[1536 + 512 + c], b2 = cb[512 + c];
        const float w00 = cw[c], w01 = cw[768 + c], w02 = cw[1536 + c], b0 = cb[c];
        const bf16_t* u0 = HT + ((size_t)((2 * bp) * 1024)) * L; const bf16_t* u1 = HT + ((size_t)((2 * bp + 1) * 1024)) * L;
#pragma unroll
        for (int u = 0; u < 2; ++u) { const int t0 = (tid + 512 * u) * 8;
          float a1[8], a2[8], c1[8], c2[8];
          sconv8(u0 + (size_t)(512 + c) * L, t0, L, lane, w20, w21, w22, b2, a2); sconv8(u0 + (size_t)(256 + c) * L, t0, L, lane, w10, w11, w12, b1, a1);
          sconv8(u1 + (size_t)(512 + c) * L, t0, L, lane, w20, w21, w22, b2, c2); sconv8(u1 + (size_t)(256 + c) * L, t0, L, lane, w10, w11, w12, b1, c1);
#pragma unroll
          for (int j = 0; j < 4; ++j) { f32x4 v = {a1[2 * j] * a2[2 * j], c1[2 * j] * c2[2 * j], a1[2 * j + 1] * a2[2 * j + 1], c1[2 * j + 1] * c2[2 * j + 1]};
            *(f32x4*)(x + t0 + 2 * j) = v; const f32x4 z = {0.f, 0.f, 0.f, 0.f}; *(f32x4*)(x + L + t0 + 2 * j) = z; } }
        __syncthreads();
        fft_fwd(x, TW, tid);
        { const f32x4* kf = (const f32x4*)(KF + ((size_t)l * 256 + c) * NFFT);
#pragma unroll 4
          for (int u = 0; u < 16; ++u) { const int i = tid + 512 * u; const f32x4 a = *(const f32x4*)(x + 2 * i), k = kf[i];
            f32x4 r = {a[0] * k[0] - a[1] * k[1], a[0] * k[1] + a[1] * k[0], a[2] * k[2] - a[3] * k[3], a[2] * k[3] + a[3] * k[2]}; *(f32x4*)(x + 2 * i) = r; } }
        __syncthreads();
        fft_inv(x, TW, tid);
        const float bias = p.hbias[l * 256 + c];
#pragma unroll
        for (int u = 0; u < 2; ++u) { const int t0 = (tid + 512 * u) * 8;
          f32x4 yv[4];
#pragma unroll
          for (int j = 0; j < 4; ++j) yv[j] = *(const f32x4*)(x + t0 + 2 * j);
#pragma unroll
          for (int q = 0; q < 2; ++q) { const bf16_t* uu = q ? u1 : u0; const int b = 2 * bp + q;
            float a1[8], a2[8], a0[8];
            sconv8(uu + (size_t)(512 + c) * L, t0, L, lane, w20, w21, w22, b2, a2); sconv8(uu + (size_t)(256 + c) * L, t0, L, lane, w10, w11, w12, b1, a1);
            sconv8(uu + (size_t)c * L, t0, L, lane, w00, w01, w02, b0, a0);
            const u32x4 hgv = *(const u32x4*)(uu + (size_t)(768 + c) * L + t0);
            float r[8];
#pragma unroll
            for (int j = 0; j < 8; ++j) { const float yy = yv[j >> 1][(j & 1) * 2 + q]; const float hg = (j & 1) ? bhi(hgv[j >> 1]) : blo(hgv[j >> 1]);
              r[j] = a0[j] * (yy + bias * (a1[j] * a2[j])) * silu(hg); }
            u32x4 w; w[0] = cvtpk(r[0], r[1]); w[1] = cvtpk(r[2], r[3]); w[2] = cvtpk(r[4], r[5]); w[3] = cvtpk(r[6], r[7]);
            *(u32x4*)(YHT + ((size_t)(b * 256 + c)) * L + t0) = w; } }
      }
      if ((PHM & 2048) && l == 0) for (int it = bid; it < 256; it += G) {
        __syncthreads(); RETID();
        const int c = it;
        float* hf = (float*)lds; float* hb = hf + 256; float* zz = hb + 256; float* red = zz + 1024;
        float part = 0.f;
        if (tid < 256) { const float v = HKC[(size_t)c * CT + tid]; hf[tid] = v; part = fabsf(v); } else { const int t = tid - 256; const float v = HKC[(size_t)(256 + c) * CT + t]; hb[t] = v; part = t > 0 ? fabsf(v) : 0.f; }
        const float inv = 1.f / (block_sum(part, red, tid) + EPS);
        const float* cw = p.conv_w; const float* cb = p.conv_b;
        const float w10 = cw[256 + c], w11 = cw[768 + 256 + c], w12 = cw[1536 + 256 + c], b1 = cb[256 + c];
        const float w20 = cw[512 + c], w21 = cw[768 + 512 + c], w22 = cw[1536 + 512 + c], b2 = cb[512 + c];
        const float w00 = cw[c], w01 = cw[768 + c], w02 = cw[1536 + c], b0 = cb[c];
        for (int i = tid; i < 1024; i += 512) { const int b = i >> 8, t = i & 255; const bf16_t* uu = HTC + (size_t)(b * 1024) * CT;
          zz[i] = sconv(uu + (size_t)(512 + c) * CT, t, CT, w20, w21, w22, b2) * sconv(uu + (size_t)(256 + c) * CT, t, CT, w10, w11, w12, b1); }
        __syncthreads();
        const float bias = p.hbias[c];
        for (int i = tid; i < 1024; i += 512) { const int b = i >> 8, t = i & 255; const float* zb = zz + b * 256; float acc = 0.f;
          for (int s = 0; s <= t; ++s) acc += zb[s] * hf[t - s];
          for (int s = t + 1; s < 256; ++s) acc += zb[s] * hb[s - t];
          const bf16_t* uu = HTC + (size_t)(b * 1024) * CT;
          const float x0 = sconv(uu + (size_t)c * CT, t, CT, w00, w01, w02, b0), hg = bf2f(uu[(size_t)(768 + c) * CT + t]);
          Y[(size_t)(TL + b * CT + t) * 1024 + 768 + c] = f2bf(x0 * (acc * inv + bias * zb[t]) * silu(hg)); }
      }
    }
    GSYNC();

    REWS();
    for (int rep = 0; rep < REP_D2; ++rep) {
      const bool ctx_here = (l == 0) && (G == 256);
      if (ctx_here && bid < 32) {
        EpiOut e{xl, xc, p.out, XC, modl};
        GArgs g{Y, 1024, WOUT + (size_t)l * 1024 * 1024, 1024, 1024, nullptr, 0};
        gemm_tile<2, false, true>(lds, g, (TL / 256 + (bid >> 3)) * 256, (bid & 7) * 128, e);
      } else
      for (int it = (ctx_here ? bid - 32 : bid); it < 2048; it += (ctx_here ? G - 32 : G)) {
        __syncthreads(); RETID();
        const bf16_t* src; int ld, tokbase, cb;
        { const int b = it >> 9, cblk = (it >> 7) & 3, tblk = it & 127; src = YHT + ((size_t)(b * 256 + cblk * 64)) * L + tblk * 64; ld = L; tokbase = b * L + tblk * 64; cb = cblk * 64; }
        unsigned* tile = (unsigned*)lds;
        { const int c = tid >> 3, ch = tid & 7; const u32x4 v = *(const u32x4*)(src + (size_t)c * ld + ch * 8);
          unsigned* tp = tile + c * 33 + ch * 4; tp[0] = v[0]; tp[1] = v[1]; tp[2] = v[2]; tp[3] = v[3]; }
        __syncthreads();
        { const int t = tid >> 3, cch = tid & 7; const bf16_t* tb = (const bf16_t*)tile; unsigned e[8];
#pragma unroll
          for (int j = 0; j < 8; ++j) e[j] = tb[(cch * 8 + j) * 66 + t];
          u32x4 w; w[0] = e[0] | (e[1] << 16); w[1] = e[2] | (e[3] << 16); w[2] = e[4] | (e[5] << 16); w[3] = e[6] | (e[7] << 16);
          *(u32x4*)(Y + (size_t)(tokbase + t) * 1024 + 768 + cb + cch * 8) = w; }
      }
    }
    GSYNC();
    REWS();
    for (int rep = 0; rep < (l == 0 ? REP_E0 : 1); ++rep) if (PHM & 64) {
      const int NM = (l == 0 && G != 256) ? TA / 256 : TL / 256; const int NTILES = NM * 8;
      EpiOut e{xl, xc, p.out, XC, modl};
      GArgs g{Y, 1024, WOUT + (size_t)l * 1024 * 1024, 1024, 1024, nullptr, 0};
      if (G == 256) { const int xcd = bid & 7, slot = bid >> 3;
        for (int mg = xcd; mg * 4 < NM; mg += 8) { const int m = mg * 4 + (slot & 3), n = slot >> 2;
          if (m < NM) gemm_tile<2, false, true>(lds, g, m * 256, n * 128, e); }
      } else for (int it = bid; it < NTILES; it += G) { const int m = it >> 3, n = it & 7;
        gemm_tile<2, false, true>(lds, g, m * 256, n * 128, e);
      }
    }
    GSYNC();
  }
  RETID();
  for (int row0 = bid * 8 + wid; row0 < TL; row0 += G * 16) {
    f32x4 a[2][4]; float ss[2] = {0.f, 0.f};
#pragma unroll
    for (int rr = 0; rr < 2; ++rr) { const int row = row0 + rr * G * 8; if (row < TL) { const float* src = p.out + (size_t)row * DM;
#pragma unroll
        for (int i = 0; i < 4; ++i) { a[rr][i] = *(const f32x4*)(src + 4 * (lane + 64 * i)); ss[rr] += a[rr][i][0] * a[rr][i][0] + a[rr][i][1] * a[rr][i][1] + a[rr][i][2] * a[rr][i][2] + a[rr][i][3] * a[rr][i][3]; } } }
#pragma unroll
    for (int rr = 0; rr < 2; ++rr) { const int row = row0 + rr * G * 8; if (row < TL) { float* src = p.out + (size_t)row * DM;
        const float rstd = rsqrtf(wave_sum(ss[rr]) * (1.f / DM) + EPS);
#pragma unroll
        for (int i = 0; i < 4; ++i) { const int col = 4 * (lane + 64 * i); const f32x4 g = *(const f32x4*)(p.fnorm + col);
          f32x4 o = {a[rr][i][0] * rstd * g[0], a[rr][i][1] * rstd * g[1], a[rr][i][2] * rstd * g[2], a[rr][i][3] * rstd * g[3]}; *(f32x4*)(src + col) = o; } } }
  }
}

#undef p
extern "C" void kernel_launch(void* const* d_in, const int* in_sizes, int n_in, void* d_out, int out_size, void* d_ws, size_t ws_size, hipStream_t stream) {
  static int grid_blocks = 0;
  if (!grid_blocks) {
    int dev = 0, cus = 0, per_cu = 0;
    hipGetDevice(&dev);
    hipDeviceGetAttribute(&cus, hipDeviceAttributeMultiprocessorCount, dev);
    hipOccupancyMaxActiveBlocksPerMultiprocessor(&per_cu, mega, 512, 0);
    if (per_cu < 1) per_cu = 1;
    grid_blocks = cus * 1;
    if (ws_size < WS_END) fprintf(stderr, "kernel_launch: workspace too small: %zu < %zu\n", ws_size, (size_t)WS_END);
  }
  P p{};
  const float** pp = (const float**)&p;
  for (int i = 0; i < 25; ++i) pp[i] = (const float*)d_in[i];
  p.out = (float*)d_out; p.ws = (char*)d_ws;
  void* args[] = {&p};
  hipError_t e = hipLaunchCooperativeKernel((void*)mega, dim3(grid_blocks), dim3(512), args, 0, stream);
  if (e != hipSuccess) fprintf(stderr, "cooperative launch failed: %s (grid %d)\n", hipGetErrorString(e), grid_blocks);
}
```
